# Optimizing an MI355X kernel written in HIP

```python
import jax, jax.numpy as jnp
from jax import lax
import numpy as np

D_MODEL = 2048
BATCH = 8
SEQ = 2048
DEPTH = 4

N_MIXERS = 4
HEAD_DIM = 128
N_HEADS = D_MODEL // HEAD_DIM
Q_BLOCK = 128
EPS = 1e-6

FOX_FGATE_BIAS = 2.0

MLA_Q_RANK = 512
MLA_KV_RANK = 512
MLA_NOPE = 128
MLA_ROPE = 64
MLA_V = 128
ROPE_THETA = 10000.0

SGU_CHUNK = 128
SGU_WIDTH = D_MODEL
SGU_GROUP_DIM = 128
SGU_GROUPS = SGU_WIDTH // SGU_GROUP_DIM

D_FF = 5632
CONV_WIDTH = 3

kernel_name = 'hybrid_interleaved_fox_mla_stickbreak_sgu'


def _n_layers_of(m):
    return len(range(m, DEPTH, N_MIXERS))


def rms_norm(x, gain):
    x32 = x.astype(jnp.float32)
    y = x32 * lax.rsqrt(jnp.mean(x32 * x32, axis=-1, keepdims=True) + EPS)
    return (y * gain.astype(jnp.float32)).astype(x.dtype)


def _sweep_query_blocks(block_fn, seq):
    out = lax.map(block_fn, jnp.arange(seq // Q_BLOCK))
    nb, b, qb, h, dv = out.shape
    return out.transpose(1, 0, 2, 3, 4).reshape(b, seq, h * dv)


def _causal_softmax(s, start, v):
    seq = s.shape[-1]
    q_pos = start + jnp.arange(Q_BLOCK)
    allowed = jnp.arange(seq)[None, :] <= q_pos[:, None]
    p = jax.nn.softmax(jnp.where(allowed, s, -jnp.inf), axis=-1)
    return jnp.einsum('bhqs,bshd->bqhd', p.astype(v.dtype), v)


def fox_mixer(h, w_in, b_f, q_gain, k_gain, w_out):
    bsz, seq, _ = h.shape
    hd = N_HEADS * HEAD_DIM
    q, k, v, f_logit = jnp.split(h @ w_in, [hd, 2 * hd, 3 * hd], axis=-1)
    q = rms_norm(q.reshape(bsz, seq, N_HEADS, HEAD_DIM), q_gain)
    k = rms_norm(k.reshape(bsz, seq, N_HEADS, HEAD_DIM), k_gain)
    v = v.reshape(bsz, seq, N_HEADS, HEAD_DIM)
    log_f = jax.nn.log_sigmoid(f_logit.astype(jnp.float32) + b_f.astype(jnp.float32))
    cum = jnp.cumsum(log_f, axis=1).transpose(0, 2, 1)
    scale = HEAD_DIM ** -0.5

    def block(i):
        start = i * Q_BLOCK
        qb = lax.dynamic_slice_in_dim(q, start, Q_BLOCK, axis=1)
        cq = lax.dynamic_slice_in_dim(cum, start, Q_BLOCK, axis=2)
        s = jnp.einsum('bqhd,bshd->bhqs', qb, k, preferred_element_type=jnp.float32) * scale
        s = s + (cq[..., :, None] - cum[:, :, None, :])
        return _causal_softmax(s, start, v)

    return _sweep_query_blocks(block, seq) @ w_out


def _rope_tables(positions):
    inv_freq = ROPE_THETA ** (-jnp.arange(0, MLA_ROPE, 2, dtype=jnp.float32) / MLA_ROPE)
    ang = positions.astype(jnp.float32)[..., None] * inv_freq
    return jnp.cos(ang)[:, :, None, :], jnp.sin(ang)[:, :, None, :]


def _apply_rope(x, cos, sin):
    x1, x2 = jnp.split(x.astype(jnp.float32), 2, axis=-1)
    return jnp.concatenate([x1 * cos - x2 * sin, x1 * sin + x2 * cos], axis=-1).astype(x.dtype)


def mla_mixer(h, positions, w_in, q_a_gain, kv_a_gain, w_q_b, w_kv_b, q_gain, k_gain, w_out):
    bsz, seq, _ = h.shape
    c_q, c_kv, k_rope = jnp.split(h @ w_in, [MLA_Q_RANK, MLA_Q_RANK + MLA_KV_RANK], axis=-1)
    q = (rms_norm(c_q, q_a_gain) @ w_q_b).reshape(bsz, seq, N_HEADS, MLA_NOPE + MLA_ROPE)
    kv = (rms_norm(c_kv, kv_a_gain) @ w_kv_b).reshape(bsz, seq, N_HEADS, MLA_NOPE + MLA_V)
    q_nope, q_rope = jnp.split(q, [MLA_NOPE], axis=-1)
    k_nope, v = jnp.split(kv, [MLA_NOPE], axis=-1)
    cos, sin = _rope_tables(positions)
    q_nope = rms_norm(q_nope, q_gain[:MLA_NOPE])
    k_nope = rms_norm(k_nope, k_gain[:MLA_NOPE])
    q_rope = _apply_rope(rms_norm(q_rope, q_gain[MLA_NOPE:]), cos, sin)
    k_rope = _apply_rope(rms_norm(k_rope[:, :, None, :], k_gain[MLA_NOPE:]), cos, sin)
    q = jnp.concatenate([q_nope, q_rope], axis=-1)
    k = jnp.concatenate([k_nope, jnp.broadcast_to(k_rope, (bsz, seq, N_HEADS, MLA_ROPE))], axis=-1)
    scale = (MLA_NOPE + MLA_ROPE) ** -0.5

    def block(i):
        start = i * Q_BLOCK
        qb = lax.dynamic_slice_in_dim(q, start, Q_BLOCK, axis=1)
        s = jnp.einsum('bqhd,bshd->bhqs', qb, k, preferred_element_type=jnp.float32) * scale
        return _causal_softmax(s, start, v)

    return _sweep_query_blocks(block, seq) @ w_out


def stick_breaking_mixer(h, w_in, q_gain, k_gain, w_out):
    bsz, seq, _ = h.shape
    hd = N_HEADS * HEAD_DIM
    q, k, v = jnp.split(h @ w_in, [hd, 2 * hd], axis=-1)
    q = rms_norm(q.reshape(bsz, seq, N_HEADS, HEAD_DIM), q_gain)
    k = rms_norm(k.reshape(bsz, seq, N_HEADS, HEAD_DIM), k_gain)
    v = v.reshape(bsz, seq, N_HEADS, HEAD_DIM)
    scale = HEAD_DIM ** -0.5

    def block(i):
        start = i * Q_BLOCK
        qb = lax.dynamic_slice_in_dim(q, start, Q_BLOCK, axis=1)
        z = jnp.einsum('bqhd,bshd->bhqs', qb, k, preferred_element_type=jnp.float32) * scale
        q_pos = start + jnp.arange(Q_BLOCK)
        strict = jnp.arange(seq)[None, :] < q_pos[:, None]
        log_keep = jnp.where(strict, -jax.nn.softplus(z), 0.0)
        after = lax.cumsum(log_keep, axis=3, reverse=True) - log_keep
        a = jnp.where(strict, jnp.exp(jax.nn.log_sigmoid(z) + after), 0.0)
        return jnp.einsum('bhqs,bshd->bqhd', a.astype(v.dtype), v)

    return _sweep_query_blocks(block, seq) @ w_out


def sgu_mixer(h, w_in, v_gain, w_s, b_s, w_out):
    bsz, seq, _ = h.shape
    u, vv = jnp.split(jax.nn.gelu(h @ w_in), 2, axis=-1)
    vv = rms_norm(vv, v_gain)
    n_chunks = seq // SGU_CHUNK
    vv = vv.reshape(bsz, n_chunks, SGU_CHUNK, SGU_GROUPS, SGU_GROUP_DIM)
    causal = jnp.tril(jnp.ones((SGU_CHUNK, SGU_CHUNK), dtype=bool))
    ws = jnp.where(causal[None], w_s, 0.0).astype(vv.dtype)
    mixed = jnp.einsum('gts,bnsgc->bntgc', ws, vv) + b_s.T[:, :, None]
    return (u * mixed.reshape(bsz, seq, SGU_WIDTH)) @ w_out


def conv_ffn(h, w_up, conv_w, conv_b, w_down):
    seq = h.shape[1]
    up = h @ w_up
    padded = jnp.pad(up, ((0, 0), (CONV_WIDTH - 1, 0), (0, 0)))
    y = conv_b + conv_w[0] * padded[:, 0:seq]
    for tap in range(1, CONV_WIDTH):
        y = y + conv_w[tap] * padded[:, tap:tap + seq]
    gate, val = jnp.split(y, 2, axis=-1)
    return (jax.nn.silu(gate) * val) @ w_down


def setup_inputs(seed: int = 0) -> dict:
    key = jax.random.key(seed)
    ks = iter(list(jax.random.split(key, 32)))

    def w(shape, fan_in):
        return jax.random.normal(next(ks), shape, jnp.float32) * fan_in ** -0.5

    def gain(shape):
        return 1.0 + 0.1 * jax.random.normal(next(ks), shape, jnp.float32)

    n_a, n_b, n_c, n_d = (_n_layers_of(m) for m in range(N_MIXERS))
    hd = N_HEADS * HEAD_DIM
    x = jax.random.normal(next(ks), (BATCH, SEQ, D_MODEL), jnp.float32)
    offset = jax.random.randint(next(ks), (BATCH, 1), 0, 4096, dtype=jnp.int32)
    positions = offset + jnp.arange(SEQ, dtype=jnp.int32)[None, :]
    return {
        'x': x,
        'positions': positions,
        'mix_norm': gain((DEPTH, D_MODEL)),
        'ffn_norm': gain((DEPTH, D_MODEL)),
        'fox_w_in': w((n_a, D_MODEL, 3 * hd + N_HEADS), D_MODEL),
        'fox_b_f': FOX_FGATE_BIAS + 0.5 * jax.random.normal(next(ks), (n_a, N_HEADS), jnp.float32),
        'fox_q_gain': gain((n_a, HEAD_DIM)),
        'fox_k_gain': gain((n_a, HEAD_DIM)),
        'fox_w_out': w((n_a, hd, D_MODEL), hd),
        'mla_w_in': w((n_b, D_MODEL, MLA_Q_RANK + MLA_KV_RANK + MLA_ROPE), D_MODEL),
        'mla_q_a_gain': gain((n_b, MLA_Q_RANK)),
        'mla_kv_a_gain': gain((n_b, MLA_KV_RANK)),
        'mla_w_q_b': w((n_b, MLA_Q_RANK, N_HEADS * (MLA_NOPE + MLA_ROPE)), MLA_Q_RANK),
        'mla_w_kv_b': w((n_b, MLA_KV_RANK, N_HEADS * (MLA_NOPE + MLA_V)), MLA_KV_RANK),
        'mla_q_gain': gain((n_b, MLA_NOPE + MLA_ROPE)),
        'mla_k_gain': gain((n_b, MLA_NOPE + MLA_ROPE)),
        'mla_w_out': w((n_b, N_HEADS * MLA_V, D_MODEL), N_HEADS * MLA_V),
        'sb_w_in': w((n_c, D_MODEL, 3 * hd), D_MODEL),
        'sb_q_gain': gain((n_c, HEAD_DIM)),
        'sb_k_gain': gain((n_c, HEAD_DIM)),
        'sb_w_out': w((n_c, hd, D_MODEL), hd),
        'sgu_w_in': w((n_d, D_MODEL, 2 * SGU_WIDTH), D_MODEL),
        'sgu_v_gain': gain((n_d, SGU_WIDTH)),
        'sgu_w_s': w((n_d, SGU_GROUPS, SGU_CHUNK, SGU_CHUNK), SGU_CHUNK),
        'sgu_b_s': gain((n_d, SGU_GROUPS, SGU_CHUNK)),
        'sgu_w_out': w((n_d, SGU_WIDTH, D_MODEL), SGU_WIDTH),
        'ffn_w_up': w((DEPTH, D_MODEL, 2 * D_FF), D_MODEL),
        'ffn_conv_w': w((DEPTH, CONV_WIDTH, 2 * D_FF), CONV_WIDTH),
        'ffn_conv_b': 0.01 * jax.random.normal(next(ks), (DEPTH, 2 * D_FF), jnp.float32),
        'ffn_w_down': w((DEPTH, D_FF, D_MODEL), D_FF),
    }


def reference(x, positions, mix_norm, ffn_norm,
              fox_w_in, fox_b_f, fox_q_gain, fox_k_gain, fox_w_out,
              mla_w_in, mla_q_a_gain, mla_kv_a_gain, mla_w_q_b, mla_w_kv_b,
              mla_q_gain, mla_k_gain, mla_w_out,
              sb_w_in, sb_q_gain, sb_k_gain, sb_w_out,
              sgu_w_in, sgu_v_gain, sgu_w_s, sgu_b_s, sgu_w_out,
              ffn_w_up, ffn_conv_w, ffn_conv_b, ffn_w_down):
    h = x
    for i in range(DEPTH):
        m, j = i % N_MIXERS, i // N_MIXERS
        a = rms_norm(h, mix_norm[i])
        if m == 0:
            mixed = fox_mixer(a, fox_w_in[j], fox_b_f[j], fox_q_gain[j], fox_k_gain[j], fox_w_out[j])
        elif m == 1:
            mixed = mla_mixer(a, positions, mla_w_in[j], mla_q_a_gain[j], mla_kv_a_gain[j],
                              mla_w_q_b[j], mla_w_kv_b[j], mla_q_gain[j], mla_k_gain[j], mla_w_out[j])
        elif m == 2:
            mixed = stick_breaking_mixer(a, sb_w_in[j], sb_q_gain[j], sb_k_gain[j], sb_w_out[j])
        else:
            mixed = sgu_mixer(a, sgu_w_in[j], sgu_v_gain[j], sgu_w_s[j], sgu_b_s[j], sgu_w_out[j])
        h = h + mixed
        h = h + conv_ffn(rms_norm(h, ffn_norm[i]), ffn_w_up[i], ffn_conv_w[i], ffn_conv_b[i], ffn_w_down[i])
    return h
```

```cpp
#include <hip/hip_runtime.h>
#include <hip/hip_cooperative_groups.h>
#include <cstdio>
#include <cstdint>
namespace cg = cooperative_groups;

#define DI __device__ __forceinline__
#define LAS __attribute__((address_space(3)))
typedef unsigned short bf16_t;
typedef short bf16x8 __attribute__((ext_vector_type(8)));
typedef float f32x4 __attribute__((ext_vector_type(4)));
typedef float f32x2 __attribute__((ext_vector_type(2)));
typedef float f32x16 __attribute__((ext_vector_type(16)));
typedef unsigned u32x4 __attribute__((ext_vector_type(4)));
typedef unsigned u32x2 __attribute__((ext_vector_type(2)));
typedef __bf16 bf16x2_t __attribute__((ext_vector_type(2)));
typedef short s16x4 __attribute__((ext_vector_type(4)));

constexpr int M_TOK = 16384, DM = 2048, SEQ = 2048, NH = 16, DFF = 5632;
constexpr float EPS = 1e-6f;
constexpr float LOG2E = 1.4426950408889634f;

DI unsigned pk2(float lo, float hi) { f32x2 v = {lo, hi}; bf16x2_t b = __builtin_convertvector(v, bf16x2_t); return __builtin_bit_cast(unsigned, b); }
DI float bf_lo(unsigned w) { return __uint_as_float(w << 16); }
DI float bf_hi(unsigned w) { return __uint_as_float(w & 0xffff0000u); }
DI float wave_sum(float v) {
#pragma unroll
    for (int o = 1; o < 64; o <<= 1) v += __shfl_xor(v, o);
    return v;
}
DI float fast_rcp(float x) { return __builtin_amdgcn_rcpf(x); }
DI float fast_exp2(float x) { return __builtin_amdgcn_exp2f(x); }
DI float fast_log2(float x) { return __builtin_amdgcn_logf(x); }
DI float gelu_tanh(float x) { const float u = 0.7978845608028654f * (x + 0.044715f * x * x * x); return x * fast_rcp(1.f + fast_exp2(-2.f * LOG2E * u)); }
DI float silu(float x) { return x * fast_rcp(1.f + fast_exp2(-LOG2E * x)); }
#define LDS_WAIT() asm volatile("s_waitcnt lgkmcnt(0)" ::: "memory")
DI int opaque_tid(int wave_s) { unsigned m = ~0u; asm volatile("" : "+s"(m)); int l = (int)__builtin_amdgcn_mbcnt_hi(m, __builtin_amdgcn_mbcnt_lo(m, 0u)); asm volatile("" : "+v"(l)); asm volatile("" : "+s"(wave_s)); return (wave_s << 6) | l; }
DI int opaque_s(int v) { asm volatile("" : "+s"(v)); return v; }
template <class T> DI T* opaque_p(T* p) { asm volatile("" : "+s"(p)); return p; }

namespace pg8 {
constexpr int BM = 256, BK = 64, HALF = 128, HTB = HALF * BK * 2, STAGE_BYTES = 8 * HTB, NXCD = 8, WGM = 8;
__host__ __device__ __forceinline__ int lds_byte(int r, int c) { const int st = (r >> 4) * 2 + (c >> 5), rr = r & 15, cc = c & 31, ob = rr * 64 + cc * 2; return st * 1024 + (ob ^ (((ob >> 9) & 1) << 5)); }
__host__ __device__ __forceinline__ void stage_rc(int b, int& R, int& C) { const int st = b / 1024, sb = b % 1024, swz = sb ^ (((sb >> 9) & 1) << 5); R = (st >> 1) * 16 + swz / 64; C = (st & 1) * 32 + (swz % 64) / 2; }
__host__ __device__ __forceinline__ int perm32(int rho) { const int n = rho >> 4, i = rho & 15; return 8 * (i >> 2) + 4 * n + (i & 3); }

struct Unit { int pm, pn; };
struct Gemm { const bf16_t* A; int lda; const bf16_t* Bt; int ldb; int M, N, K; };

struct StaticOrder {
    int nM, nN, nwg, G, c;
    __host__ __device__ void init(int M, int N, int G_, int c_) { nM = M / BM; nN = N / BM; nwg = nM * nN; G = G_; c = c_; }
    __host__ __device__ bool next(int i, Unit& u) const {
        const long L = (long)i * G + c; if (L >= nwg) return false;
        int wgid = (int)L; { const int q = nwg / NXCD, r = nwg % NXCD, xcd = wgid % NXCD, off = wgid / NXCD; wgid = (xcd < r ? xcd * (q + 1) : r * (q + 1) + (xcd - r) * q) + off; }
        const int nig = WGM * nN, gid = wgid / nig, fm = gid * WGM, gsz = (nM - fm) < WGM ? (nM - fm) : WGM;
        u.pm = fm + ((wgid % nig) % gsz); u.pn = (wgid % nig) / gsz; return true;
    }
};

typedef f32x4 Acc[2][2][4][2];

DI float hrstd(const float* rsh, int r, int fq) {
    const char* rp = (const char*)rsh + (unsigned)((r * 32 + fq * 8) * 4);
    const f32x4 pa = *(const f32x4*)rp, pb = *(const f32x4*)(rp + 16);
    float s = ((pa[0] + pa[1]) + (pa[2] + pa[3])) + ((pb[0] + pb[1]) + (pb[2] + pb[3]));
    s += __shfl_xor(s, 16); s += __shfl_xor(s, 32);
    return __builtin_amdgcn_rsqf(s * (1.f / DM) + EPS);
}
DI float hrstd_t(const float* rsh, LAS const float* tab, int pm_base, int pm, int rl, int fq) {
    if ((unsigned)(pm - pm_base) < 8u) return tab[(pm - pm_base) * 256 + rl];
    return hrstd(rsh, pm * BM + rl, fq);
}
DI void rstd_tab_build(const float* rsh, int pm_base, LAS float* tab, int tid) {
#pragma unroll
    for (int k = 0; k < 4; ++k) {
        const int row = tid + 512 * k; const f32x4* p = (const f32x4*)(rsh + (size_t)(pm_base * BM + row) * 32);
        f32x4 a = p[0] + p[1]; f32x4 b = p[2] + p[3]; f32x4 c = p[4] + p[5]; f32x4 d = p[6] + p[7];
        a = (a + b) + (c + d);
        tab[row] = __builtin_amdgcn_rsqf(((a[0] + a[1]) + (a[2] + a[3])) * (1.f / DM) + EPS);
    }
    __syncthreads();
}
DI void rstd512_tab_build(const float* rsp, int pm_base, LAS float* tq, LAS float* tkv, int tid) {
#pragma unroll
    for (int k = 0; k < 4; ++k) {
        const int row = tid + 512 * k; const f32x4* p = (const f32x4*)(rsp + (size_t)(pm_base * BM + row) * 16);
        const f32x4 a = p[0] + p[1], b = p[2] + p[3];
        tq[row] = __builtin_amdgcn_rsqf(((a[0] + a[1]) + (a[2] + a[3])) * (1.f / 512.f) + EPS);
        tkv[row] = __builtin_amdgcn_rsqf(((b[0] + b[1]) + (b[2] + b[3])) * (1.f / 512.f) + EPS);
    }
    __syncthreads();
}
template <int ACT, int SCALE, bool ACC> struct EpiStore {
    static constexpr bool PERM = true;
    bf16_t* O; int ldc; const float* rs_in; float* rs_out; int acc_pn_lo; LAS const float* tab; int pm_base;
    DI void operator()(const Acc& acc, const Unit& u, int wr, int wc, int fr, int fq) const {
        const int row0 = u.pm * BM + wr * 64 + fr, col0 = u.pn * BM + wc * 32 + 8 * fq;
#pragma unroll
        for (int ai = 0; ai < 2; ++ai)
#pragma unroll
            for (int m = 0; m < 4; ++m) {
                const int r = row0 + ai * HALF + m * 16;
                float sc = 1.f; if (SCALE == 2) sc = hrstd_t(rs_in, tab, pm_base, u.pm, wr * 64 + fr + ai * HALF + m * 16, fq);
                if (SCALE == 1) {
                    if ((unsigned)(u.pm - pm_base) < 8u) sc = tab[(u.pm - pm_base) * 256 + wr * 64 + fr + ai * HALF + m * 16];
                    else { const f32x4 pa = *(const f32x4*)(rs_in + (size_t)r * 16), pb = *(const f32x4*)(rs_in + (size_t)r * 16 + 4);
                        sc = __builtin_amdgcn_rsqf((((pa[0] + pa[1]) + (pa[2] + pa[3])) + ((pb[0] + pb[1]) + (pb[2] + pb[3]))) * (1.f / 512.f) + EPS); } }
                float ss = 0.f;
                bf16_t* rowp = O + (size_t)r * ldc + col0;
#pragma unroll
                for (int bj = 0; bj < 2; ++bj) {
                    f32x4 v0 = acc[ai][bj][m][0], v1 = acc[ai][bj][m][1];
                    if (SCALE) { v0 = v0 * sc; v1 = v1 * sc; }
                    if (ACT == 1) {
#pragma unroll
                        for (int j = 0; j < 4; ++j) { v0[j] = gelu_tanh(v0[j]); v1[j] = gelu_tanh(v1[j]); }
                    }
                    if (ACC) ss += (v0[0] * v0[0] + v0[1] * v0[1]) + (v0[2] * v0[2] + v0[3] * v0[3]) + (v1[0] * v1[0] + v1[1] * v1[1]) + (v1[2] * v1[2] + v1[3] * v1[3]);
                    u32x4 w; w.x = pk2(v0[0], v0[1]); w.y = pk2(v0[2], v0[3]); w.z = pk2(v1[0], v1[1]); w.w = pk2(v1[2], v1[3]);
                    *(u32x4*)(rowp + bj * HALF) = w;
                }
                if (ACC) { if (u.pn >= acc_pn_lo) { ss += __shfl_xor(ss, 16); ss += __shfl_xor(ss, 32); if (fq == 0) rs_out[(size_t)r * 32 + (u.pn - acc_pn_lo) * 4 + wc] = ss; } }
            }
    }
};
template <int DQK_PITCH, int BJ_LO, int BJ_HI, class F>
DI void knorm_store(F v, bf16_t* Kn, const float* kgain, int head0, int head_bj_stride, const Unit& u, int wr, int wc, int fr, int fq, LAS float* xl) {
    const int rl0 = wr * 64 + fr;
#pragma unroll
    for (int ai = 0; ai < 2; ++ai)
#pragma unroll
        for (int m = 0; m < 4; ++m) { const int rl = ai * HALF + rl0 + m * 16;
#pragma unroll
            for (int bj = BJ_LO; bj < BJ_HI; ++bj) { const f32x4 v0 = v(ai, m, bj, 0), v1 = v(ai, m, bj, 1);
                float ss = (v0[0] * v0[0] + v0[1] * v0[1]) + (v0[2] * v0[2] + v0[3] * v0[3]) + (v1[0] * v1[0] + v1[1] * v1[1]) + (v1[2] * v1[2] + v1[3] * v1[3]);
                ss += __shfl_xor(ss, 16); ss += __shfl_xor(ss, 32); if (fq == 0) xl[(rl * 2 + bj) * 4 + wc] = ss; } }
    asm volatile("s_waitcnt lgkmcnt(0)" ::: "memory"); __builtin_amdgcn_s_barrier(); asm volatile("" ::: "memory");
    const f32x4 g0 = *(const f32x4*)(kgain + wc * 32 + 8 * fq), g1 = *(const f32x4*)(kgain + wc * 32 + 8 * fq + 4);
#pragma unroll
    for (int ai = 0; ai < 2; ++ai)
#pragma unroll
        for (int m = 0; m < 4; ++m) { const int rl = ai * HALF + rl0 + m * 16, row = u.pm * BM + rl, b = row >> 11, sq = row & (SEQ - 1);
#pragma unroll
            for (int bj = BJ_LO; bj < BJ_HI; ++bj) { const f32x4 pt = *(const LAS f32x4*)(xl + (rl * 2 + bj) * 4);
                const float r = __builtin_amdgcn_rsqf(((pt[0] + pt[1]) + (pt[2] + pt[3])) * (1.f / 128.f) + EPS);
                const f32x4 v0 = v(ai, m, bj, 0) * r * g0, v1 = v(ai, m, bj, 1) * r * g1;
                u32x4 w; w.x = pk2(v0[0], v0[1]); w.y = pk2(v0[2], v0[3]); w.z = pk2(v1[0], v1[1]); w.w = pk2(v1[2], v1[3]);
                *(u32x4*)(Kn + ((size_t)(b * 16 + head0 + bj * head_bj_stride) * SEQ + sq) * DQK_PITCH + wc * 32 + 8 * fq) = w; } }
}
template <bool FOX> struct EpiQKV {
    static constexpr bool PERM = true;
    bf16_t* O; bf16_t* Kn; const float* kgain; float* flog; const float* rsh; LAS float* xl; LAS const float* tab; int pm_base;
    DI void operator()(const Acc& acc, const Unit& u, int wr, int wc, int fr, int fq) const {
        const int row0 = u.pm * BM + wr * 64 + fr;
        float sc[2][4];
#pragma unroll
        for (int ai = 0; ai < 2; ++ai)
#pragma unroll
            for (int m = 0; m < 4; ++m) sc[ai][m] = hrstd_t(rsh, tab, pm_base, u.pm, wr * 64 + fr + ai * HALF + m * 16, fq);
        if (u.pn >= 8 && u.pn < 16) {
            knorm_store<128, 0, 2>([&](int ai, int m, int bj, int n) { return acc[ai][bj][m][n] * sc[ai][m]; }, Kn, kgain, (u.pn - 8) * 2, 1, u, wr, wc, fr, fq, xl);
        } else if (!FOX || u.pn < 24) {
            const int col0 = u.pn * BM + wc * 32 + 8 * fq;
#pragma unroll
            for (int ai = 0; ai < 2; ++ai)
#pragma unroll
                for (int m = 0; m < 4; ++m) {
                    bf16_t* rowp = O + (size_t)(row0 + ai * HALF + m * 16) * 6144 + col0;
#pragma unroll
                    for (int bj = 0; bj < 2; ++bj) {
                        const f32x4 v0 = acc[ai][bj][m][0] * sc[ai][m], v1 = acc[ai][bj][m][1] * sc[ai][m];
                        u32x4 w; w.x = pk2(v0[0], v0[1]); w.y = pk2(v0[2], v0[3]); w.z = pk2(v1[0], v1[1]); w.w = pk2(v1[2], v1[3]);
                        *(u32x4*)(rowp + bj * HALF) = w;
                    }
                }
        } else if (wc == 0 && fq < 2) {
#pragma unroll
            for (int ai = 0; ai < 2; ++ai)
#pragma unroll
                for (int m = 0; m < 4; ++m) {
                    float* rowp = flog + (size_t)(row0 + ai * HALF + m * 16) * 16 + 8 * fq;
                    *(f32x4*)(rowp) = acc[ai][0][m][0] * sc[ai][m]; *(f32x4*)(rowp + 4) = acc[ai][0][m][1] * sc[ai][m];
                }
        }
    }
};
struct EpiMlaKV {
    static constexpr bool PERM = true;
    bf16_t* KV; bf16_t* Kn; const float* kgain; const float* rs_in; LAS float* xl; LAS const float* tab; int pm_base;
    DI void operator()(const Acc& acc, const Unit& u, int wr, int wc, int fr, int fq) const {
        const int row0 = u.pm * BM + wr * 64 + fr;
        float sc[2][4];
#pragma unroll
        for (int ai = 0; ai < 2; ++ai)
#pragma unroll
            for (int m = 0; m < 4; ++m) { const int r = row0 + ai * HALF + m * 16;
                if ((unsigned)(u.pm - pm_base) < 8u) sc[ai][m] = tab[(u.pm - pm_base) * 256 + wr * 64 + fr + ai * HALF + m * 16];
                else { const f32x4 pa = *(const f32x4*)(rs_in + (size_t)r * 16), pb = *(const f32x4*)(rs_in + (size_t)r * 16 + 4);
                    sc[ai][m] = __builtin_amdgcn_rsqf((((pa[0] + pa[1]) + (pa[2] + pa[3])) + ((pb[0] + pb[1]) + (pb[2] + pb[3]))) * (1.f / 512.f) + EPS); } }
#pragma unroll
        for (int ai = 0; ai < 2; ++ai)
#pragma unroll
            for (int m = 0; m < 4; ++m) {
                const f32x4 v0 = acc[ai][1][m][0] * sc[ai][m], v1 = acc[ai][1][m][1] * sc[ai][m];
                u32x4 w; w.x = pk2(v0[0], v0[1]); w.y = pk2(v0[2], v0[3]); w.z = pk2(v1[0], v1[1]); w.w = pk2(v1[2], v1[3]);
                *(u32x4*)(KV + (size_t)(row0 + ai * HALF + m * 16) * 4096 + u.pn * BM + HALF + wc * 32 + 8 * fq) = w;
            }
        knorm_store<192, 0, 1>([&](int ai, int m, int bj, int n) { return acc[ai][bj][m][n] * sc[ai][m]; }, Kn, kgain, u.pn, 0, u, wr, wc, fr, fq, xl);
    }
};
struct EpiMlaIn {
    static constexpr bool PERM = true;
    bf16_t* O; float* rsp; float* krope; const float* rsh; LAS const float* tab; int pm_base;
    DI void operator()(const Acc& acc, const Unit& u, int wr, int wc, int fr, int fq) const {
        const int row0 = u.pm * BM + wr * 64 + fr;
        float sc[2][4];
#pragma unroll
        for (int ai = 0; ai < 2; ++ai)
#pragma unroll
            for (int m = 0; m < 4; ++m) sc[ai][m] = hrstd_t(rsh, tab, pm_base, u.pm, wr * 64 + fr + ai * HALF + m * 16, fq);
        if (u.pn < 4) {
            const int col0 = u.pn * BM + wc * 32 + 8 * fq;
#pragma unroll
            for (int ai = 0; ai < 2; ++ai)
#pragma unroll
                for (int m = 0; m < 4; ++m) {
                    const int r = row0 + ai * HALF + m * 16;
                    bf16_t* rowp = O + (size_t)r * 1024 + col0; float ss = 0.f;
#pragma unroll
                    for (int bj = 0; bj < 2; ++bj) {
                        const f32x4 v0 = acc[ai][bj][m][0] * sc[ai][m], v1 = acc[ai][bj][m][1] * sc[ai][m];
                        ss += (v0[0] * v0[0] + v0[1] * v0[1]) + (v0[2] * v0[2] + v0[3] * v0[3]) + (v1[0] * v1[0] + v1[1] * v1[1]) + (v1[2] * v1[2] + v1[3] * v1[3]);
                        u32x4 w; w.x = pk2(v0[0], v0[1]); w.y = pk2(v0[2], v0[3]); w.z = pk2(v1[0], v1[1]); w.w = pk2(v1[2], v1[3]);
                        *(u32x4*)(rowp + bj * HALF) = w;
                    }
                    ss += __shfl_xor(ss, 16); ss += __shfl_xor(ss, 32); if (fq == 0) rsp[(size_t)r * 16 + u.pn * 4 + wc] = ss;
                }
        } else if (wc < 2) {
#pragma unroll
            for (int ai = 0; ai < 2; ++ai)
#pragma unroll
                for (int m = 0; m < 4; ++m) {
                    float* rowp = krope + (size_t)(row0 + ai * HALF + m * 16) * 64 + wc * 32 + 8 * fq;
                    *(f32x4*)(rowp) = acc[ai][0][m][0] * sc[ai][m]; *(f32x4*)(rowp + 4) = acc[ai][0][m][1] * sc[ai][m];
                }
        }
    }
};
template <bool BASE_F32, bool OUT_F32> struct EpiResid {
    static constexpr bool PERM = true;
    const float* base; float* out; bf16_t* xb; float* rsh;
    DI void operator()(const Acc& acc, const Unit& u, int wr, int wc, int fr, int fq) const {
        const int row0 = u.pm * BM + wr * 64 + fr, col0 = u.pn * BM + wc * 32 + 8 * fq;
#pragma unroll
        for (int ai = 0; ai < 2; ++ai)
#pragma unroll
            for (int m = 0; m < 4; ++m) {
                const int r = row0 + ai * HALF + m * 16; const size_t off = (size_t)r * DM + col0; float ss = 0.f;
#pragma unroll
                for (int bj = 0; bj < 2; ++bj) {
                    f32x4 v0, v1;
                    if (BASE_F32) { v0 = *(const f32x4*)(base + off + bj * HALF); v1 = *(const f32x4*)(base + off + bj * HALF + 4); }
                    else { const u32x4 b = *(const u32x4*)(xb + off + bj * HALF); v0 = (f32x4){bf_lo(b.x), bf_hi(b.x), bf_lo(b.y), bf_hi(b.y)}; v1 = (f32x4){bf_lo(b.z), bf_hi(b.z), bf_lo(b.w), bf_hi(b.w)}; }
                    v0 = v0 + acc[ai][bj][m][0]; v1 = v1 + acc[ai][bj][m][1];
                    if (OUT_F32) { *(f32x4*)(out + off + bj * HALF) = v0; *(f32x4*)(out + off + bj * HALF + 4) = v1; }
                    else {
                        ss += (v0[0] * v0[0] + v0[1] * v0[1]) + (v0[2] * v0[2] + v0[3] * v0[3]) + (v1[0] * v1[0] + v1[1] * v1[1]) + (v1[2] * v1[2] + v1[3] * v1[3]);
                        u32x4 w; w.x = pk2(v0[0], v0[1]); w.y = pk2(v0[2], v0[3]); w.z = pk2(v1[0], v1[1]); w.w = pk2(v1[2], v1[3]);
                        *(u32x4*)(xb + off + bj * HALF) = w;
                    }
                }
                if (!OUT_F32) { ss += __shfl_xor(ss, 16); ss += __shfl_xor(ss, 32); if (fq == 0) rsh[(size_t)r * 32 + u.pn * 4 + wc] = ss; }
            }
    }
};

DI float dpp_ror1(float v) { return __builtin_bit_cast(float, __builtin_amdgcn_update_dpp(0, __builtin_bit_cast(int, v), 0x121, 0xf, 0xf, false)); }
DI float dpp_ror2(float v) { return __builtin_bit_cast(float, __builtin_amdgcn_update_dpp(0, __builtin_bit_cast(int, v), 0x122, 0xf, 0xf, false)); }
DI unsigned dpp_ror1u(unsigned v) { return (unsigned)__builtin_amdgcn_mov_dpp((int)v, 0x121, 0xf, 0xf, false); }
DI unsigned dpp_ror2u(unsigned v) { return (unsigned)__builtin_amdgcn_mov_dpp((int)v, 0x122, 0xf, 0xf, false); }
DI unsigned dpp_shr1u(unsigned old, unsigned v) { return (unsigned)__builtin_amdgcn_update_dpp((int)old, (int)v, 0x111, 0xf, 0xf, false); }
DI unsigned dpp_shr2u(unsigned old, unsigned v) { return (unsigned)__builtin_amdgcn_update_dpp((int)old, (int)v, 0x112, 0xf, 0xf, false); }
struct EpiUpConv {
    static constexpr bool PERM = true;
    bf16_t* act; const float* rsh; const float* cw; const float* cb; float* halo; LAS float* xl; LAS const float* tab; int pm_base;
    static DI f32x4 conv4(u32x2 cur, u32x2& p1, u32x2& p2, bool f1, bool f2, f32x4 w0, f32x4 w1, f32x4 w2, f32x4 bb) {
        u32x2 s1, s2; s1.x = dpp_shr1u(p1.x, cur.x); s1.y = dpp_shr1u(p1.y, cur.y); s2.x = dpp_shr2u(p2.x, cur.x); s2.y = dpp_shr2u(p2.y, cur.y);
        p1.x = dpp_ror1u(cur.x); p1.y = dpp_ror1u(cur.y); p2.x = dpp_ror2u(cur.x); p2.y = dpp_ror2u(cur.y);
        f32x4 y;
        y[0] = bb[0] + w0[0] * bf_lo(s2.x) + w1[0] * bf_lo(s1.x) + w2[0] * bf_lo(cur.x);
        y[1] = bb[1] + w0[1] * bf_hi(s2.x) + w1[1] * bf_hi(s1.x) + w2[1] * bf_hi(cur.x);
        y[2] = bb[2] + w0[2] * bf_lo(s2.y) + w1[2] * bf_lo(s1.y) + w2[2] * bf_lo(cur.y);
        y[3] = bb[3] + w0[3] * bf_hi(s2.y) + w1[3] * bf_hi(s1.y) + w2[3] * bf_hi(cur.y);
        return y;
    }
    DI void operator()(Acc& acc, const Unit& u, int wr, int wc, int fr, int fq) const {
        asm volatile("" : "+v"(fr), "+v"(fq));
        const int row0 = u.pm * BM + wr * 64 + fr, cl = wc * 32 + 8 * fq;
        f32x4 wg[2][4], wv[2][4];
#pragma unroll
        for (int n = 0; n < 2; ++n) {
            const int cg = u.pn * 128 + cl + 4 * n, cv = DFF + cg;
            const char* gp = (const char*)cw + (unsigned)(cg * 4); const char* vp = (const char*)cw + (unsigned)(cv * 4);
            wg[n][0] = *(const f32x4*)gp; wg[n][1] = *(const f32x4*)(gp + 8 * DFF); wg[n][2] = *(const f32x4*)(gp + 16 * DFF); wg[n][3] = *(const f32x4*)((const char*)cb + (unsigned)(cg * 4));
            wv[n][0] = *(const f32x4*)vp; wv[n][1] = *(const f32x4*)(vp + 8 * DFF); wv[n][2] = *(const f32x4*)(vp + 16 * DFF); wv[n][3] = *(const f32x4*)((const char*)cb + (unsigned)(cv * 4));
        }
        u32x2 pk[2][2][4][2];
        float scv[2][4];
#pragma unroll
        for (int ai = 0; ai < 2; ++ai)
#pragma unroll
            for (int m = 0; m < 4; ++m) scv[ai][m] = hrstd_t(rsh, tab, pm_base, u.pm, wr * 64 + fr + ai * HALF + m * 16, fq);
#pragma unroll
        for (int ai = 0; ai < 2; ++ai)
#pragma unroll
            for (int m = 0; m < 4; ++m) { const float sc = scv[ai][m];
#pragma unroll
                for (int bj = 0; bj < 2; ++bj) {
                    const f32x4 v0 = acc[ai][bj][m][0] * sc, v1 = acc[ai][bj][m][1] * sc;
                    if (m == 3 && fr >= 14) { LAS float* d = xl + ((((ai * 2 + wr) * 2 + bj) * 2 + (fr - 14)) * 128) + cl; *(LAS f32x4*)d = v0; *(LAS f32x4*)(d + 4) = v1; }
                    if (ai == 0 && m == 0 && wr == 0 && fr < 2) { float* d = (float*)((char*)halo + (unsigned)((((u.pm * 2 + bj) * 4 + fr) * DFF + u.pn * 128 + cl) * 4)); *(f32x4*)d = v0; *(f32x4*)(d + 4) = v1; }
                    if (ai == 1 && m == 3 && wr == 1 && fr >= 14) { float* d = (float*)((char*)halo + (unsigned)((((u.pm * 2 + bj) * 4 + 2 + (fr - 14)) * DFF + u.pn * 128 + cl) * 4)); *(f32x4*)d = v0; *(f32x4*)(d + 4) = v1; }
                    pk[ai][bj][m][0].x = pk2(v0[0], v0[1]); pk[ai][bj][m][0].y = pk2(v0[2], v0[3]); pk[ai][bj][m][1].x = pk2(v1[0], v1[1]); pk[ai][bj][m][1].y = pk2(v1[2], v1[3]);
                }
                __builtin_amdgcn_sched_barrier(0); }
        asm volatile("s_waitcnt lgkmcnt(0)" ::: "memory"); __builtin_amdgcn_s_barrier(); asm volatile("" ::: "memory");
        const bool f1 = fr >= 1, f2 = fr >= 2;
#pragma unroll
        for (int n = 0; n < 2; ++n) {
            const int cg = u.pn * 128 + cl + 4 * n;
            const f32x4 g0 = wg[n][0], g1 = wg[n][1], g2 = wg[n][2], gb = wg[n][3], v0 = wv[n][0], v1 = wv[n][1], v2 = wv[n][2], vbb = wv[n][3];
#pragma unroll
            for (int ai = 0; ai < 2; ++ai) {
                const int sg = wr == 1 ? ai * 2 : 1;
                f32x4 bg_ = *(const LAS f32x4*)(xl + (((sg * 2 + 0) * 2 + (fr & 1)) * 128) + cl + 4 * n), bv_ = *(const LAS f32x4*)(xl + (((sg * 2 + 1) * 2 + (fr & 1)) * 128) + cl + 4 * n);
                if ((ai | wr) == 0) { bg_ = (f32x4){0.f, 0.f, 0.f, 0.f}; bv_ = bg_; }
                u32x2 tg, tv; tg.x = pk2(bg_[0], bg_[1]); tg.y = pk2(bg_[2], bg_[3]); tv.x = pk2(bv_[0], bv_[1]); tv.y = pk2(bv_[2], bv_[3]);
                u32x2 pg1, pg2, pv1, pv2; pg1.x = dpp_ror1u(tg.x); pg1.y = dpp_ror1u(tg.y); pg2.x = dpp_ror2u(tg.x); pg2.y = dpp_ror2u(tg.y);
                pv1.x = dpp_ror1u(tv.x); pv1.y = dpp_ror1u(tv.y); pv2.x = dpp_ror2u(tv.x); pv2.y = dpp_ror2u(tv.y);
#pragma unroll
                for (int m = 0; m < 4; ++m) {
                    const f32x4 yv = conv4(pk[ai][1][m][n], pv1, pv2, f1, f2, v0, v1, v2, vbb);
                    const f32x4 yg = conv4(pk[ai][0][m][n], pg1, pg2, f1, f2, g0, g1, g2, gb);
                    u32x2 w; w.x = pk2(silu(yg[0]) * yv[0], silu(yg[1]) * yv[1]); w.y = pk2(silu(yg[2]) * yv[2], silu(yg[3]) * yv[3]);
                    *(u32x2*)((char*)act + (unsigned)(((row0 + ai * HALF + m * 16) * DFF + cg) * 2)) = w;
                    __builtin_amdgcn_sched_barrier(0);
                }
            }
        }
    }
};

template <class Epi, class Sched, bool ALIGN_EPI = true, bool SP2 = true>
DI void gemm_phase(LAS unsigned char* lds, const Gemm g, const Sched& S, const Epi& E, int wave_s) {
    const int tid = opaque_tid(wave_s), wid = __builtin_amdgcn_readfirstlane(tid >> 6), lane = tid & 63, wr = wid >> 2, wc = wid & 3, fr = lane & 15, fq = lane >> 4;
    const int K = g.K, nt = K / BK;
    unsigned voffA[2], voffB[2];
#pragma unroll
    for (int i = 0; i < 2; ++i) { int R, C; stage_rc(tid * 16 + i * 8192, R, C); const int Rb = Epi::PERM ? ((R & ~31) + perm32(R & 31)) : R;
        voffA[i] = (unsigned)(R * g.lda + C) * 2u; voffB[i] = (unsigned)(Rb * g.ldb + C) * 2u; }
    const size_t kstep = (size_t)(BK * 2);
    const size_t hstepA = (size_t)HALF * g.lda * 2, hstepB = (size_t)HALF * g.ldb * 2;
    const size_t tstepA = 2 * hstepA, tstepB = 2 * hstepB;
    const unsigned ldsw = (unsigned)wid * 1024u;
    const int aoff = lds_byte(wr * 64 + fr, fq * 8), boff = lds_byte(wc * 32 + fr, fq * 8);
#define PG8_SA(b, h) (((b) * 2 + (h)) * HTB)
#define PG8_SB(b, h) ((4 + (b) * 2 + (h)) * HTB)
#define PG8_STAGE(bufoff, gbase, voff) do { _Pragma("unroll") for (int _i = 0; _i < 2; ++_i) \
        __builtin_amdgcn_global_load_lds((const unsigned*)((const char*)(gbase) + (voff)[_i]), (LAS unsigned*)(lds + (bufoff) + ldsw + _i * 8192), 16, 0, 0); } while (0)
#define PG8_LDA(dst, b, h) do { _Pragma("unroll") for (int m = 0; m < 4; ++m) _Pragma("unroll") for (int k = 0; k < 2; ++k) dst[m][k] = *(const LAS bf16x8*)(lds + PG8_SA(b, h) + aoff + m * 2048 + k * 1024); } while (0)
#define PG8_LDB(dst, b, h) do { _Pragma("unroll") for (int n = 0; n < 2; ++n) _Pragma("unroll") for (int k = 0; k < 2; ++k) dst[n][k] = *(const LAS bf16x8*)(lds + PG8_SB(b, h) + boff + n * 2048 + k * 1024); } while (0)
#define PG8_MMA(ai, bj, At, Bt) do { __builtin_amdgcn_s_setprio(1); _Pragma("unroll") for (int m = 0; m < 4; ++m) _Pragma("unroll") for (int n = 0; n < 2; ++n) _Pragma("unroll") for (int k = 0; k < 2; ++k) \
        acc[ai][bj][m][n] = __builtin_amdgcn_mfma_f32_16x16x32_bf16(Bt[n][k], At[m][k], acc[ai][bj][m][n], 0, 0, 0); __builtin_amdgcn_s_setprio(0); } while (0)
#define PG8_WAIT_V(n) asm volatile("s_waitcnt vmcnt(" #n ")" ::: "memory")
#define PG8_WAIT_L(n) asm volatile("s_waitcnt lgkmcnt(" #n ")" ::: "memory")
#define PG8_BAR __builtin_amdgcn_s_barrier()
#define PG8_SCHED __builtin_amdgcn_sched_barrier(0)
    Unit cur, nxt; int ui = 0;
    if (!S.next(0, cur)) return;
    f32x4 acc[2][2][4][2];
#pragma unroll
    for (int a = 0; a < 2; ++a)
#pragma unroll
        for (int b = 0; b < 2; ++b)
#pragma unroll
            for (int m = 0; m < 4; ++m)
#pragma unroll
                for (int n = 0; n < 2; ++n) acc[a][b][m][n] = (f32x4){0.f, 0.f, 0.f, 0.f};
    bf16x8 At[4][2], B0[2][2], B1[2][2];
    const char* cA = (const char*)g.A + (size_t)cur.pm * tstepA; const char* cB = (const char*)g.Bt + (size_t)cur.pn * tstepB;
    {
        PG8_STAGE(PG8_SB(0, 0), cB, voffB); PG8_STAGE(PG8_SB(0, 1), cB + hstepB, voffB); PG8_STAGE(PG8_SA(0, 0), cA, voffA); PG8_STAGE(PG8_SA(0, 1), cA + hstepA, voffA);
        if (wr == 1) PG8_BAR;
        PG8_WAIT_V(2); PG8_BAR;
        PG8_STAGE(PG8_SB(1, 0), cB + kstep, voffB); PG8_STAGE(PG8_SA(1, 0), cA + kstep, voffA); PG8_STAGE(PG8_SB(1, 1), cB + hstepB + kstep, voffB);
        PG8_WAIT_V(6); PG8_BAR;
    }
    for (;;) {
        const bool has_next = S.next(ui + 1, nxt);
        const char* nA = has_next ? (const char*)g.A + (size_t)nxt.pm * tstepA : cA; const char* nB = has_next ? (const char*)g.Bt + (size_t)nxt.pn * tstepB : cB;
        for (int t = 0; t < nt; t += 2) {
            const bool last = (t == nt - 2);
            const char* a1 = cA + (size_t)(t + 1) * kstep;
            const char* a2 = last ? nA : cA + (size_t)(t + 2) * kstep; const char* b2 = last ? nB : cB + (size_t)(t + 2) * kstep;
            const char* a3 = a2 + kstep; const char* b3 = b2 + kstep;
            PG8_LDB(B0, 0, 0); PG8_LDB(B1, 0, 1); PG8_SCHED; PG8_LDA(At, 0, 0); PG8_STAGE(PG8_SA(1, 1), a1 + hstepA, voffA);
            PG8_WAIT_V(8); PG8_WAIT_L(0); PG8_BAR; PG8_MMA(0, 0, At, B0); PG8_MMA(0, 1, At, B1); PG8_BAR; PG8_SCHED;
            PG8_LDA(At, 0, 1); PG8_STAGE(PG8_SB(0, 0), b2, voffB); PG8_STAGE(PG8_SB(0, 1), b2 + hstepB, voffB); PG8_STAGE(PG8_SA(0, 0), a2, voffA);
            PG8_WAIT_V(8); PG8_WAIT_L(0); PG8_BAR; PG8_MMA(1, 0, At, B0); PG8_MMA(1, 1, At, B1); PG8_BAR; PG8_SCHED;
            PG8_LDB(B0, 1, 0); PG8_LDB(B1, 1, 1); PG8_SCHED; PG8_LDA(At, 1, 0); PG8_STAGE(PG8_SA(0, 1), a2 + hstepA, voffA);
            PG8_WAIT_V(8); PG8_WAIT_L(0); PG8_BAR; PG8_MMA(0, 0, At, B0); PG8_MMA(0, 1, At, B1); PG8_BAR; PG8_SCHED;
            PG8_LDA(At, 1, 1); PG8_STAGE(PG8_SB(1, 0), b3, voffB); PG8_STAGE(PG8_SB(1, 1), b3 + hstepB, voffB); PG8_STAGE(PG8_SA(1, 0), a3, voffA);
            PG8_WAIT_V(8); PG8_WAIT_L(0); PG8_BAR; PG8_MMA(1, 0, At, B0); PG8_MMA(1, 1, At, B1); PG8_BAR; PG8_SCHED;
        }
        if constexpr (ALIGN_EPI) { if (wr == 0) PG8_BAR; }
        E(acc, cur, wr, wc, fr, fq);
        if (!has_next) break;
#pragma unroll
        for (int a = 0; a < 2; ++a)
#pragma unroll
            for (int b = 0; b < 2; ++b)
#pragma unroll
                for (int m = 0; m < 4; ++m)
#pragma unroll
                    for (int n = 0; n < 2; ++n) acc[a][b][m][n] = (f32x4){0.f, 0.f, 0.f, 0.f};
        cur = nxt; cA = nA; cB = nB; ++ui;
        if constexpr (ALIGN_EPI) { if (wr == 1) PG8_BAR; }
    }
    PG8_WAIT_V(0);
    if constexpr (!ALIGN_EPI) { if (wr == 0) PG8_BAR; }
    PG8_BAR;
#undef PG8_SA
#undef PG8_SB
#undef PG8_STAGE
#undef PG8_LDA
#undef PG8_LDB
#undef PG8_MMA
#undef PG8_WAIT_V
#undef PG8_WAIT_L
#undef PG8_BAR
#undef PG8_SCHED
}
}

constexpr size_t MiB = 1u << 20;
constexpr size_t WS_RSH = 390 * MiB, WS_RSP = 12 * MiB, WS_RSSGU = 13 * MiB;
constexpr size_t WS_FLOG = 1 * MiB, WS_CUM = 2 * MiB, WS_KROPE = 4 * MiB, WS_RCS = 8 * MiB, WS_RSN = 10 * MiB;
constexpr size_t WS_W = 16 * MiB;
constexpr size_t W_FOX_IN = WS_W, W_FOX_OUT = W_FOX_IN + 25 * MiB, W_MLA_IN = W_FOX_OUT + 8 * MiB, W_MLA_QB = W_MLA_IN + 5 * MiB, W_MLA_KVB = W_MLA_QB + 3 * MiB,
                 W_MLA_OUT = W_MLA_KVB + 4 * MiB, W_SB_IN = W_MLA_OUT + 8 * MiB, W_SB_OUT = W_SB_IN + 24 * MiB, W_SGU_IN = W_SB_OUT + 8 * MiB, W_SGU_OUT = W_SGU_IN + 16 * MiB,
                 W_UP = W_SGU_OUT + 8 * MiB, W_DOWN = W_UP + 4 * 44 * MiB, W_END = W_DOWN + 4 * 22 * MiB;
constexpr size_t WS_XB = 400 * MiB, WS_BIG = 464 * MiB, WS_ACT = 816 * MiB, WS_HALO = 992 * MiB, WS_END = 1004 * MiB;
static_assert(W_END <= WS_XB, "weights fit");

DI void convert_matrix(const float* __restrict__ W, const float* __restrict__ gain, bf16_t* __restrict__ WT, int K, int N, int Npad, LAS float* scrf, int gw, int NGW, int lane, bool perm_up = false) {
    LAS unsigned* scr = (LAS unsigned*)scrf;
    const int nblk = Npad / 64, nitems = (K / 64) * nblk;
    const int c = lane & 15, g = lane >> 4;
    for (int it = gw; it < nitems; it += NGW) {
        const int kb = it / nblk, nb = it % nblk, k0 = 64 * kb, n0 = 64 * nb;
        const int n = n0 + 4 * c; const bool ok = n < N;
        const int nd0 = !perm_up ? n0 : (n0 < DFF ? (n0 >> 7) * 256 + (n0 & 127) : ((n0 - DFF) >> 7) * 256 + 128 + ((n0 - DFF) & 127));
        f32x4 v[16];
        const float* wp = W + (size_t)(k0 + 2 * g) * N + n;
#pragma unroll
        for (int j = 0; j < 8; ++j)
#pragma unroll
            for (int e = 0; e < 2; ++e) v[2 * j + e] = ok ? __builtin_nontemporal_load((const f32x4*)(wp + (size_t)(8 * j + e) * N)) : (f32x4){0.f, 0.f, 0.f, 0.f};
        if (gain) {
#pragma unroll
            for (int j = 0; j < 8; ++j) { const f32x2 gg = *(const f32x2*)(gain + k0 + 8 * j + 2 * g); v[2 * j] = v[2 * j] * gg.x; v[2 * j + 1] = v[2 * j + 1] * gg.y; }
        }
#pragma unroll
        for (int j = 0; j < 8; ++j)
#pragma unroll
            for (int q = 0; q < 4; ++q) scr[(4 * c + q) * 33 + 4 * j + g] = pk2(v[2 * j][q], v[2 * j + 1][q]);
        LDS_WAIT();
#pragma unroll
        for (int i = 0; i < 8; ++i) {
            const int nl = (lane >> 3) + 8 * i, q = lane & 7; const LAS unsigned* sp = scr + nl * 33 + 4 * q;
            u32x4 o; o.x = sp[0]; o.y = sp[1]; o.z = sp[2]; o.w = sp[3];
            *(u32x4*)(WT + (size_t)(nd0 + nl) * K + k0 + 8 * q) = o;
        }
        LDS_WAIT();
    }
}

DI void norm_phase(const float* __restrict__ h, bf16_t* __restrict__ xb, float* __restrict__ rsh, int vcu, int G, int wave_s) {
    const int tid = opaque_tid(wave_s), lane = tid & 63, gw = vcu * 8 + (tid >> 6), NGW = G * 8;
    for (int r = gw; r < M_TOK; r += NGW) {
        const f32x4* xr = (const f32x4*)(h + (size_t)r * DM) + lane;
        f32x4 v[8]; float s = 0.f;
#pragma unroll
        for (int j = 0; j < 8; ++j) { v[j] = xr[64 * j]; s += (v[j].x * v[j].x + v[j].y * v[j].y) + (v[j].z * v[j].z + v[j].w * v[j].w); }
        s = wave_sum(s);
        if (lane < 32) rsh[(size_t)r * 32 + lane] = lane == 0 ? s : 0.f;
        u32x2* o = (u32x2*)(xb + (size_t)r * DM) + lane;
#pragma unroll
        for (int j = 0; j < 8; ++j) { u32x2 w; w.x = pk2(v[j].x, v[j].y); w.y = pk2(v[j].z, v[j].w); o[64 * j] = w; }
    }
}

DI void unpack8(const u32x4 w, float* f) { f[0] = bf_lo(w.x); f[1] = bf_hi(w.x); f[2] = bf_lo(w.y); f[3] = bf_hi(w.y); f[4] = bf_lo(w.z); f[5] = bf_hi(w.z); f[6] = bf_lo(w.w); f[7] = bf_hi(w.w); }
template <int MODE>
DI void kvprep_phase(LAS unsigned char* lds, const bf16_t* __restrict__ src, bf16_t* __restrict__ Kn, bf16_t* __restrict__ Vt, const float* __restrict__ kgain,
                     const float* __restrict__ flog, const float* __restrict__ bfp, float* __restrict__ cum, const float* __restrict__ krope, const float* __restrict__ rcs, const float* __restrict__ rsn,
                     int vcu, int G, int wave_s) {
    constexpr int DQK = MODE == 1 ? 192 : 128, LDS_ = MODE == 1 ? 4096 : 6144;
    const int tid = opaque_tid(wave_s), lane = tid & 63, wid = tid >> 6;
    if (MODE == 0) {
        const int gw = vcu * 8 + wid, NGW = G * 8;
        for (int q = gw; q < 128; q += NGW) {
            const int b = q >> 4, h = q & 15; const float bh_ = bfp[h];
            const float* fl = flog + (size_t)(b * SEQ + 32 * lane) * 16 + h;
            float lf[32]; float tot = 0.f;
#pragma unroll
            for (int j = 0; j < 32; ++j) { const float x = fl[j * 16] + bh_; lf[j] = -(fmaxf(-x, 0.f) + 0.6931471805599453f * fast_log2(1.f + fast_exp2(-LOG2E * fabsf(x)))); tot += lf[j]; }
            float incl = tot;
#pragma unroll
            for (int o = 1; o < 64; o <<= 1) { const float y = __shfl_up(incl, o); if (lane >= o) incl += y; }
            float run = incl - tot;
            float* co = cum + (size_t)q * SEQ + 32 * lane;
#pragma unroll
            for (int j = 0; j < 32; j += 4) { f32x4 o4; run += lf[j]; o4[0] = run; run += lf[j + 1]; o4[1] = run; run += lf[j + 2]; o4[2] = run; run += lf[j + 3]; o4[3] = run; *(f32x4*)(co + j) = o4; }
        }
    }
    if (MODE == 1) {
        constexpr int NIT = M_TOK * 16 * 4;
        const int gt = vcu * 512 + tid, GT = G * 512;
        for (int i = gt; i < NIT; i += GT) {
            const int cc = i & 3, h = (i >> 2) & 15, row = i >> 6;
            const float* kr = krope + (size_t)row * 64 + 8 * cc;
            const f32x4 a0 = *(const f32x4*)kr, a1 = *(const f32x4*)(kr + 4), b0 = *(const f32x4*)(kr + 32), b1 = *(const f32x4*)(kr + 36);
            float x1[8] = {a0[0], a0[1], a0[2], a0[3], a1[0], a1[1], a1[2], a1[3]}, x2[8] = {b0[0], b0[1], b0[2], b0[3], b1[0], b1[1], b1[2], b1[3]};
            float s2 = 0.f;
#pragma unroll
            for (int j = 0; j < 8; ++j) s2 += x1[j] * x1[j] + x2[j] * x2[j];
            s2 += __shfl_xor(s2, 1); s2 += __shfl_xor(s2, 2);
            const float rs = __builtin_amdgcn_rsqf(s2 * (1.f / 64.f) + EPS);
            float r1[8], r2[8];
            const f32x4 c0 = *(const f32x4*)(rcs + (size_t)row * 32 + 8 * cc), c1 = *(const f32x4*)(rcs + (size_t)row * 32 + 8 * cc + 4), n0 = *(const f32x4*)(rsn + (size_t)row * 32 + 8 * cc), n1 = *(const f32x4*)(rsn + (size_t)row * 32 + 8 * cc + 4);
#pragma unroll
            for (int j = 0; j < 8; ++j) {
                const int ii = 8 * cc + j;
                const float cs = j < 4 ? c0[j & 3] : c1[j & 3], sn = j < 4 ? n0[j & 3] : n1[j & 3];
                const float y1 = x1[j] * rs * kgain[128 + ii], y2 = x2[j] * rs * kgain[160 + ii];
                r1[j] = y1 * cs - y2 * sn; r2[j] = y1 * sn + y2 * cs;
            }
            const int b = row >> 11, sq = row & (SEQ - 1);
            bf16_t* ro = Kn + ((size_t)(b * 16 + h) * SEQ + sq) * DQK + 128 + 8 * cc;
            u32x4 w1, w2; w1.x = pk2(r1[0], r1[1]); w1.y = pk2(r1[2], r1[3]); w1.z = pk2(r1[4], r1[5]); w1.w = pk2(r1[6], r1[7]);
            w2.x = pk2(r2[0], r2[1]); w2.y = pk2(r2[2], r2[3]); w2.z = pk2(r2[4], r2[5]); w2.w = pk2(r2[6], r2[7]);
            *(u32x4*)ro = w1; *(u32x4*)(ro + 32) = w2;
        }
    }
}

#define MFMA32(a, b, c) __builtin_amdgcn_mfma_f32_32x32x16_bf16((a), (b), (c), 0, 0, 0)
template <int MODE>
DI void attn_phase(LAS unsigned char* lds, const bf16_t* __restrict__ Q, int ldq, int qhs, const bf16_t* __restrict__ Kn, const bf16_t* __restrict__ Vsrc, int ldv, int vhs,
                   const float* __restrict__ cum, const float* qgain, const float* __restrict__ rcs, const float* __restrict__ rsn, bf16_t* __restrict__ O, int vcu, int G, int wave_s) {
    constexpr int DQK = MODE == 1 ? 192 : 128, NST = DQK / 16, KP = DQK * 2 + 16, KBUF = 64 * KP, VP = 272, VBUF = 64 * VP, KCH = DQK / 8, KPT = 64 * KCH / 512;
    constexpr int OFF_V = 2 * KBUF, OFF_C = OFF_V + 3 * VBUF;
    const int tid = opaque_tid(wave_s), lane = tid & 63, w = __builtin_amdgcn_readfirstlane(tid >> 6), r32 = lane & 31, hi = lane >> 5;
    const float CS = (MODE == 1 ? 0.07216878364870322f : 0.08838834764831845f) * LOG2E;
    float fox_thr = 0.f;
    if constexpr (MODE == 0) {
        float gq = fmaxf(fabsf(qgain[lane]), fabsf(qgain[lane + 64])), gk = fmaxf(fabsf(rcs[lane]), fabsf(rcs[lane + 64]));
#pragma unroll
        for (int o = 1; o < 64; o <<= 1) { gq = fmaxf(gq, __shfl_xor(gq, o)); gk = fmaxf(gk, __shfl_xor(gk, o)); }
        fox_thr = 2.02f * (128.f * CS * gq * gk) + 160.f;
    }
    const int pim = (r32 & 0x13) | ((r32 & 4) << 1) | ((r32 & 8) >> 1);
    const unsigned kfo = pim * KP + hi * 16;
    const unsigned vfo = (unsigned)((8 * hi + ((lane & 15) >> 2)) * VP + ((lane >> 4) & 1) * 32 + (lane & 3) * 8);
    for (int g = vcu; g < 512; g += G) {
        const int bh = g >> 2, par_ = (MODE == 0 && G >= 4) ? ((bh / (G >> 2)) & 1) : 0, sub = par_ ? 3 - (g & 3) : (g & 3), b = bh >> 4, h = bh & 15;
        const bf16_t* Kbh = Kn + (size_t)bh * SEQ * DQK; const bf16_t* Vbh = Vsrc + (size_t)b * SEQ * ldv + h * vhs; const float* cbh = cum + (size_t)bh * SEQ;
        for (int k4 = 0; k4 < 2; ++k4) {
            const int qb = (k4 == 0) ? 7 - sub : sub;
            const int q0 = qb * 256, NT = 4 * (qb + 1);
            int toff = 0;
            if constexpr (MODE == 0) {
                const float cq0 = cbh[q0];
                const bool far_ = lane < NT && (cbh[64 * (lane < NT ? lane : 0) + 63] - cq0) * LOG2E >= fox_thr;
                toff = (int)__popcll(__ballot(far_)); if (toff > NT - 1) toff = NT - 1;
                toff = __builtin_amdgcn_readfirstlane(toff);
            }
            const int NTe = NT - toff;
            const int qmin = q0 + 32 * w, qmax = qmin + 31, qg = qmin + r32;
            bf16x8 qf[NST];
            {
                const float* qgl = qgain; asm volatile("" : "+s"(qgl));
                int r32q = r32, hiq = hi; asm volatile("" : "+v"(r32q), "+v"(hiq));
                const bf16_t* qrow = (Q + (size_t)(b * SEQ + qmin) * ldq + h * qhs) + (unsigned)(r32q * ldq + 8 * hiq);
                u32x4 raw[NST];
#pragma unroll
                for (int st = 0; st < NST; ++st) raw[st] = *(const u32x4*)(qrow + 16 * st);
                float ssn = 0.f;
#pragma unroll
                for (int st = 0; st < 8; ++st) { float f[8]; unpack8(raw[st], f);
#pragma unroll
                    for (int j = 0; j < 8; ++j) ssn += f[j] * f[j]; }
                ssn += __shfl_xor(ssn, 32);
                const float rn = CS / sqrtf(ssn * (1.f / 128.f) + EPS);
#pragma unroll
                for (int st = 0; st < 8; ++st) { float f[8]; unpack8(raw[st], f);
                    const f32x4 g0 = *(const f32x4*)(qgl + 16 * st + 8 * hi), g1 = *(const f32x4*)(qgl + 16 * st + 8 * hi + 4);
                    u32x4 o; o.x = pk2(f[0] * rn * g0[0], f[1] * rn * g0[1]); o.y = pk2(f[2] * rn * g0[2], f[3] * rn * g0[3]);
                    o.z = pk2(f[4] * rn * g1[0], f[5] * rn * g1[1]); o.w = pk2(f[6] * rn * g1[2], f[7] * rn * g1[3]);
                    qf[st] = __builtin_bit_cast(bf16x8, o); }
                if constexpr (MODE == 1) {
                    float ssr = 0.f;
#pragma unroll
                    for (int st = 8; st < 12; ++st) { float f[8]; unpack8(raw[st], f);
#pragma unroll
                        for (int j = 0; j < 8; ++j) ssr += f[j] * f[j]; }
                    ssr += __shfl_xor(ssr, 32);
                    const float rr = 1.0f / sqrtf(ssr * (1.f / 64.f) + EPS);
                    const float* tc = (rcs + (size_t)(b * SEQ + qmin) * 32) + (unsigned)(r32q * 32 + 8 * hiq); const float* tn = (rsn + (size_t)(b * SEQ + qmin) * 32) + (unsigned)(r32q * 32 + 8 * hiq);
#pragma unroll
                    for (int a = 0; a < 2; ++a) {
                        float f1[8], f2[8], o1[8], o2[8]; unpack8(raw[8 + a], f1); unpack8(raw[10 + a], f2);
                        const f32x4 c0 = *(const f32x4*)(tc + 16 * a), c1 = *(const f32x4*)(tc + 16 * a + 4), n0 = *(const f32x4*)(tn + 16 * a), n1 = *(const f32x4*)(tn + 16 * a + 4);
#pragma unroll
                        for (int j = 0; j < 8; ++j) {
                            const int i = 16 * a + 8 * hi + j;
                            const float cs = j < 4 ? c0[j & 3] : c1[j & 3], sn = j < 4 ? n0[j & 3] : n1[j & 3];
                            const float y1 = f1[j] * rr * qgl[128 + i], y2 = f2[j] * rr * qgl[160 + i];
                            o1[j] = (y1 * cs - y2 * sn) * CS; o2[j] = (y1 * sn + y2 * cs) * CS;
                        }
                        u32x4 w1, w2; w1.x = pk2(o1[0], o1[1]); w1.y = pk2(o1[2], o1[3]); w1.z = pk2(o1[4], o1[5]); w1.w = pk2(o1[6], o1[7]);
                        w2.x = pk2(o2[0], o2[1]); w2.y = pk2(o2[2], o2[3]); w2.z = pk2(o2[4], o2[5]); w2.w = pk2(o2[6], o2[7]);
                        qf[8 + a] = __builtin_bit_cast(bf16x8, w1); qf[10 + a] = __builtin_bit_cast(bf16x8, w2);
                    }
                }
            }
            float m_run = -INFINITY, l_run = 0.f, carry = 1.f;
            f32x16 o[4];
#pragma unroll
            for (int d = 0; d < 4; ++d)
#pragma unroll
                for (int i = 0; i < 16; ++i) o[d][i] = 0.f;
            u32x4 kreg[KPT], vreg[2]; float creg = 0.f;
            int tidu = tid; asm volatile("" : "+v"(tidu));
            const unsigned kgo = (unsigned)(tidu * KPT * 16), vgo = (unsigned)(((tidu >> 3) * ldv + (tidu & 7) * 16) * 2);
            const unsigned klo = (unsigned)(((tidu * KPT) / KCH) * KP + ((tidu * KPT) % KCH) * 16), vlo = (unsigned)((tidu >> 3) * VP + (tidu & 7) * 32);
#define ATT_LOAD(t_) do { const int s0_ = (t_) * 64; const char* kg_ = (const char*)(Kbh + (size_t)s0_ * DQK) + kgo; const char* vg_ = (const char*)(Vbh + (size_t)s0_ * ldv) + vgo; \
        _Pragma("unroll") for (int i_ = 0; i_ < KPT; ++i_) kreg[i_] = *(const u32x4*)(kg_ + i_ * 16); \
        _Pragma("unroll") for (int i_ = 0; i_ < 2; ++i_) vreg[i_] = *(const u32x4*)(vg_ + i_ * 16); \
        if (MODE == 0) { if (tid < 64) creg = cbh[s0_ + tid] * LOG2E; } } while (0)
#define ATT_STORE(buf_, vbuf_) do { LAS unsigned char* kb_ = lds + (buf_) * KBUF + klo; \
        _Pragma("unroll") for (int i_ = 0; i_ < KPT; ++i_) *(LAS u32x4*)(kb_ + i_ * 16) = kreg[i_]; \
        LAS unsigned char* vb_ = lds + OFF_V + (vbuf_) * VBUF + vlo; \
        _Pragma("unroll") for (int i_ = 0; i_ < 2; ++i_) *(LAS u32x4*)(vb_ + i_ * 16) = vreg[i_]; \
        if (MODE == 0) { if (tid < 64) ((LAS float*)(lds + OFF_C))[(buf_) * 64 + tid] = creg; } } while (0)
#define ATT_PV(vbi_) do { LAS const unsigned char* vb = lds + OFF_V + (vbi_) * VBUF + vfo; \
        _Pragma("unroll") for (int d = 0; d < 4; ++d) { \
            _Pragma("unroll") for (int s_ = 0; s_ < 4; ++s_) { \
                const s16x4 vlo_ = __builtin_bit_cast(s16x4, __builtin_amdgcn_ds_read_tr16_b64_v4i16((LAS s16x4*)(vb + s_ * 16 * VP + d * 64))); \
                const s16x4 vhi_ = __builtin_bit_cast(s16x4, __builtin_amdgcn_ds_read_tr16_b64_v4i16((LAS s16x4*)(vb + (s_ * 16 + 4) * VP + d * 64))); \
                const bf16x8 vf = __builtin_shufflevector(vlo_, vhi_, 0, 1, 2, 3, 4, 5, 6, 7); \
                o[d] = MFMA32(vf, pf[s_], o[d]); } \
            __builtin_amdgcn_sched_barrier(0); } } while (0)
            const bool late = w >= 4; bool havep = false; int vprev = 0;
            bf16x8 pf[4];
#pragma unroll
            for (int i = 0; i < 4; ++i) pf[i] = (bf16x8){0, 0, 0, 0, 0, 0, 0, 0};
            ATT_LOAD((MODE == 2) ? NT - 1 : toff); ATT_STORE(0, 0); __syncthreads();
            int vcur = 0;
            for (int it = 0; it < NTe; ++it) {
                const int t = (MODE == 2) ? NT - 1 - it : it + toff, tn = (MODE == 2) ? t - 1 : t + 1; const bool more = it + 1 < NTe; const int buf = it & 1;
                if (more) ATT_LOAD(tn);
                if (havep) { ATT_PV(vprev); havep = false; }
                if (64 * t <= qmax) {
                    LAS const unsigned char* kb = lds + buf * KBUF + kfo;
                    f32x16 p0, p1;
#pragma unroll
                    for (int i = 0; i < 16; ++i) { p0[i] = 0.f; p1[i] = 0.f; }
#pragma unroll
                    for (int st = 0; st < NST; ++st) {
                        const bf16x8 k0 = *(LAS const bf16x8*)(kb + st * 32), k1 = *(LAS const bf16x8*)(kb + 32 * KP + st * 32);
                        p0 = MFMA32(k0, qf[st], p0); p1 = MFMA32(k1, qf[st], p1);
                        if ((st & 7) == 7) __builtin_amdgcn_sched_barrier(0);
                    }
                    if constexpr (MODE == 0) {
                        LAS const float* cb = (LAS const float*)(lds + OFF_C) + buf * 64 + 8 * hi;
#pragma unroll
                        for (int a = 0; a < 2; ++a) {
                            const f32x4 c0 = *(LAS const f32x4*)(cb + 16 * a), c1 = *(LAS const f32x4*)(cb + 16 * a + 4), c2 = *(LAS const f32x4*)(cb + 32 + 16 * a), c3 = *(LAS const f32x4*)(cb + 32 + 16 * a + 4);
#pragma unroll
                            for (int j = 0; j < 4; ++j) { p0[8 * a + j] -= c0[j]; p0[8 * a + 4 + j] -= c1[j]; p1[8 * a + j] -= c2[j]; p1[8 * a + 4 + j] -= c3[j]; }
                        }
                    }
                    if (64 * t + 63 >= qmin) {
#pragma unroll
                        for (int i = 0; i < 16; ++i) {
                            const int key = 64 * t + 16 * (i >> 3) + 8 * hi + (i & 7);
                            const bool m0 = (MODE == 2) ? (key >= qg) : (key > qg), m1 = (MODE == 2) ? (key + 32 >= qg) : (key + 32 > qg);
                            if (m0) p0[i] = -INFINITY; if (m1) p1[i] = -INFINITY;
                        }
                    }
                    if constexpr (MODE != 2) {
                        float mx = p0[0];
#pragma unroll
                        for (int i = 1; i < 16; ++i) mx = fmaxf(mx, p0[i]);
#pragma unroll
                        for (int i = 0; i < 16; ++i) mx = fmaxf(mx, p1[i]);
                        mx = fmaxf(mx, __shfl_xor(mx, 32));
                        const float m_new = fmaxf(m_run, mx);
                        const float alpha = fast_exp2(m_run - m_new);
                        m_run = m_new;
                        float rs = 0.f;
#pragma unroll
                        for (int i = 0; i < 16; ++i) { p0[i] = fast_exp2(p0[i] - m_new); p1[i] = fast_exp2(p1[i] - m_new); rs += p0[i] + p1[i]; }
                        l_run = l_run * alpha + rs;
                        if (!__all(alpha == 1.0f)) {
#pragma unroll
                            for (int d = 0; d < 4; ++d)
#pragma unroll
                                for (int i = 0; i < 16; ++i) o[d][i] *= alpha;
                        }
                    } else {
                        f32x16 l0, l1;
#pragma unroll
                        for (int i = 0; i < 16; ++i) {
                            const float e0_ = fast_exp2(fminf(p0[i], 100.f)), e1_ = fast_exp2(fminf(p1[i], 100.f));
                            l0[i] = fast_rcp(1.f + e0_); l1[i] = fast_rcp(1.f + e1_);
                            p0[i] = e0_ * l0[i]; p1[i] = e1_ * l1[i];
                            if ((i & 3) == 3) __builtin_amdgcn_sched_barrier(0);
                        }
                        __builtin_amdgcn_sched_barrier(0);
                        float own0 = 1.f, own1 = 1.f, own2 = 1.f, own3 = 1.f;
#pragma unroll
                        for (int j = 0; j < 8; ++j) { own0 *= l0[j]; own1 *= l0[8 + j]; own2 *= l1[j]; own3 *= l1[8 + j]; }
                        __builtin_amdgcn_sched_barrier(0);
                        const float oth0 = __shfl_xor(own0, 32), oth1 = __shfl_xor(own1, 32), oth2 = __shfl_xor(own2, 32), oth3 = __shfl_xor(own3, 32);
                        const float so2 = own3, so1 = own3 * own2, so0 = so1 * own1;
                        const float st3 = oth3, st2 = st3 * oth2, st1 = st2 * oth1, st0 = st1 * oth0;
                        const float e0 = carry * so0 * (hi ? st1 : st0), e1 = carry * so1 * (hi ? st2 : st1), e2 = carry * so2 * (hi ? st3 : st2), e3 = carry * (hi ? 1.f : st3);
                        {
                            float run = e0;
#pragma unroll
                            for (int jj = 0; jj < 8; ++jj) { const int i = 7 - jj; p0[i] *= run; run *= l0[i]; }
                            __builtin_amdgcn_sched_barrier(0);
                            run = e1;
#pragma unroll
                            for (int jj = 0; jj < 8; ++jj) { const int i = 15 - jj; p0[i] *= run; run *= l0[i]; }
                            __builtin_amdgcn_sched_barrier(0);
                            run = e2;
#pragma unroll
                            for (int jj = 0; jj < 8; ++jj) { const int i = 7 - jj; p1[i] *= run; run *= l1[i]; }
                            __builtin_amdgcn_sched_barrier(0);
                            run = e3;
#pragma unroll
                            for (int jj = 0; jj < 8; ++jj) { const int i = 15 - jj; p1[i] *= run; run *= l1[i]; }
                        }
                        carry *= so0 * own0 * st0;
                    }
                    { u32x4 w_; w_.x = pk2(p0[0], p0[1]); w_.y = pk2(p0[2], p0[3]); w_.z = pk2(p0[4], p0[5]); w_.w = pk2(p0[6], p0[7]); pf[0] = __builtin_bit_cast(bf16x8, w_);
                      w_.x = pk2(p0[8], p0[9]); w_.y = pk2(p0[10], p0[11]); w_.z = pk2(p0[12], p0[13]); w_.w = pk2(p0[14], p0[15]); pf[1] = __builtin_bit_cast(bf16x8, w_);
                      w_.x = pk2(p1[0], p1[1]); w_.y = pk2(p1[2], p1[3]); w_.z = pk2(p1[4], p1[5]); w_.w = pk2(p1[6], p1[7]); pf[2] = __builtin_bit_cast(bf16x8, w_);
                      w_.x = pk2(p1[8], p1[9]); w_.y = pk2(p1[10], p1[11]); w_.z = pk2(p1[12], p1[13]); w_.w = pk2(p1[14], p1[15]); pf[3] = __builtin_bit_cast(bf16x8, w_); }
                    __builtin_amdgcn_sched_barrier(0);
                    if (late) { havep = true; vprev = vcur; } else { ATT_PV(vcur); }
                }
                const int vnext = vcur == 2 ? 0 : vcur + 1;
                if (more) ATT_STORE(buf ^ 1, vnext);
                vcur = vnext;
                if constexpr (MODE == 2) {
                    const bool dead_w = __all(carry < 1e-37f);
                    if (lane == 0) ((LAS unsigned*)(lds + 131072 - 64))[(it & 1) * 8 + w] = dead_w ? 1u : 0u;
                }
                __syncthreads();
                if constexpr (MODE == 2) {
                    const u32x4 f0 = *(LAS const u32x4*)(lds + 131072 - 64 + (it & 1) * 32), f1 = *(LAS const u32x4*)(lds + 131072 - 64 + (it & 1) * 32 + 16);
                    if ((f0.x & f0.y & f0.z & f0.w & f1.x & f1.y & f1.z & f1.w) != 0u) break;
                }
            }
            if (havep) { ATT_PV(vprev); }
#undef ATT_PV
#undef ATT_LOAD
#undef ATT_STORE
            float inv = 1.f;
            if constexpr (MODE != 2) { const float l = l_run + __shfl_xor(l_run, 32); inv = 1.0f / l; }
            int r32o = r32, hio = hi; asm volatile("" : "+v"(r32o), "+v"(hio));
            bf16_t* orow = (O + (size_t)(b * SEQ + qmin) * DM + h * 128) + (unsigned)(r32o * DM + 4 * hio);
#pragma unroll
            for (int d = 0; d < 4; ++d)
#pragma unroll
                for (int g4 = 0; g4 < 4; ++g4) {
                    u32x2 w_; w_.x = pk2(o[d][4 * g4] * inv, o[d][4 * g4 + 1] * inv); w_.y = pk2(o[d][4 * g4 + 2] * inv, o[d][4 * g4 + 3] * inv);
                    *(u32x2*)(orow + 32 * d + 8 * g4) = w_;
                }
            __syncthreads();
        }
    }
}

DI void sgu_phase(LAS unsigned char* lds, const bf16_t* __restrict__ uv, const float* __restrict__ rowss, const float* __restrict__ vgain, const float* __restrict__ ws,
                  const float* __restrict__ bs, bf16_t* __restrict__ Gout, int vcu, int G, int wave_s) {
    constexpr int AP = 272, OFF_VT = 128 * AP, OFF_RS = 2 * 128 * AP;
    const int tid = opaque_tid(wave_s), lane = tid & 63, w = __builtin_amdgcn_readfirstlane(tid >> 6), r32 = lane & 31, hi = lane >> 5;
    for (int su = vcu; su < 256; su += G) {
        const int g = su >> 4, c0 = (su & 15) * 8;
        __syncthreads();
#pragma unroll
        for (int i = 0; i < 8; ++i) {
            const int ci = tid + 512 * i, t = ci >> 5, s4 = (ci & 31) * 4;
            f32x4 v = *(const f32x4*)(ws + (size_t)g * 16384 + t * 128 + s4);
#pragma unroll
            for (int j = 0; j < 4; ++j) if (s4 + j > t) v[j] = 0.f;
            u32x2 o; o.x = pk2(v[0], v[1]); o.y = pk2(v[2], v[3]);
            *(LAS u32x2*)(lds + t * AP + s4 * 2) = o;
        }
        const int rr = tid >> 2, part = tid & 3;
        u32x4 raw[4]; f32x4 pa, pb;
#define SGU_LOAD(ch_) do { const int rb_ = (c0 + (ch_)) * 128; \
        _Pragma("unroll") for (int i = 0; i < 4; ++i) { const int ci = tid + 512 * i; raw[i] = *(const u32x4*)(uv + (size_t)(rb_ + (ci >> 4)) * 4096 + 2048 + g * 128 + (ci & 15) * 8); } \
        pa = *(const f32x4*)(rowss + (size_t)(rb_ + rr) * 32 + part * 8); pb = *(const f32x4*)(rowss + (size_t)(rb_ + rr) * 32 + part * 8 + 4); } while (0)
        SGU_LOAD(0);
        for (int ch = 0; ch < 8; ++ch) {
            const int rbase = (c0 + ch) * 128;
            __syncthreads();
            {
                float ssum = ((pa[0] + pa[1]) + (pa[2] + pa[3])) + ((pb[0] + pb[1]) + (pb[2] + pb[3]));
                ssum += __shfl_xor(ssum, 1); ssum += __shfl_xor(ssum, 2);
                if (part == 0) ((LAS float*)(lds + OFF_RS))[rr] = __builtin_amdgcn_rsqf(ssum * (1.f / 2048.f) + EPS);
            }
            __syncthreads();
#pragma unroll
            for (int i = 0; i < 4; ++i) {
                const int ci = tid + 512 * i, s_ = ci >> 4, cc = (ci & 15) * 8;
                const float rstd = ((LAS const float*)(lds + OFF_RS))[s_];
                float f[8]; unpack8(raw[i], f);
#pragma unroll
                for (int j = 0; j < 8; j += 2) { const unsigned pw = pk2(f[j] * rstd, f[j + 1] * rstd);
                    *(LAS bf16_t*)(lds + OFF_VT + (cc + j) * AP + s_ * 2) = (bf16_t)(pw & 0xffffu); *(LAS bf16_t*)(lds + OFF_VT + (cc + j + 1) * AP + s_ * 2) = (bf16_t)(pw >> 16); }
            }
            if (ch + 1 < 8) SGU_LOAD(ch + 1);
            const int tb = w >> 1, cb0 = (w & 1) * 2, nsteps = 2 * (tb + 1);
            const int t = 32 * tb + r32; const size_t row = (size_t)rbase + t; const float bias = bs[g * 128 + t];
            u32x2 uu[2][4];
#pragma unroll
            for (int cbk = 0; cbk < 2; ++cbk)
#pragma unroll
                for (int g4 = 0; g4 < 4; ++g4) uu[cbk][g4] = *(const u32x2*)(uv + row * 4096 + g * 128 + 32 * (cb0 + cbk) + 8 * g4 + 4 * hi);
            __syncthreads();
            f32x16 a0, a1;
#pragma unroll
            for (int i = 0; i < 16; ++i) { a0[i] = 0.f; a1[i] = 0.f; }
            LAS const unsigned char* ap = lds + (32 * tb + r32) * AP + hi * 16;
            LAS const unsigned char* vp0 = lds + OFF_VT + (32 * cb0 + r32) * AP + hi * 16;
            for (int st = 0; st < nsteps; ++st) {
                const bf16x8 bf_ = *(LAS const bf16x8*)(ap + st * 32);
                const bf16x8 v0 = *(LAS const bf16x8*)(vp0 + st * 32), v1 = *(LAS const bf16x8*)(vp0 + 32 * AP + st * 32);
                a0 = MFMA32(v0, bf_, a0); a1 = MFMA32(v1, bf_, a1);
            }
#pragma unroll
            for (int cbk = 0; cbk < 2; ++cbk)
#pragma unroll
                for (int g4 = 0; g4 < 4; ++g4) {
                    const int c = 32 * (cb0 + cbk) + 8 * g4 + 4 * hi;
                    const f32x4 vg = *(const f32x4*)(vgain + g * 128 + c);
                    const u32x2 uq = uu[cbk][g4];
                    const float u0 = bf_lo(uq.x), u1 = bf_hi(uq.x), u2 = bf_lo(uq.y), u3 = bf_hi(uq.y);
                    const float m0 = (cbk ? a1[4 * g4] : a0[4 * g4]) * vg[0] + bias, m1 = (cbk ? a1[4 * g4 + 1] : a0[4 * g4 + 1]) * vg[1] + bias;
                    const float m2 = (cbk ? a1[4 * g4 + 2] : a0[4 * g4 + 2]) * vg[2] + bias, m3 = (cbk ? a1[4 * g4 + 3] : a0[4 * g4 + 3]) * vg[3] + bias;
                    u32x2 o; o.x = pk2(u0 * m0, u1 * m1); o.y = pk2(u2 * m2, u3 * m3);
                    *(u32x2*)(Gout + row * DM + g * 128 + c) = o;
                }
        }
#undef SGU_LOAD
    }
    __syncthreads();
}

DI void convact_phase(const bf16_t* __restrict__ up, const float* __restrict__ cw, const float* __restrict__ cbias, bf16_t* __restrict__ act, int bx, int G, int wave_s) {
    const int gtid = bx * 512 + opaque_tid(wave_s), GT = G * 512;
    constexpr int FCH = DFF / 8, RS = 16, NITEMS = (M_TOK / RS) * FCH, LDU = 2 * DFF;
    for (int it = gtid; it < NITEMS; it += GT) {
        const int fc = it % FCH, strip = it / FCH, f0 = fc * 8, r0 = strip * RS;
        float wg[3][8], wv[3][8], bg[8], bv[8];
#pragma unroll
        for (int tp = 0; tp < 3; ++tp) {
            const f32x4 a = *(const f32x4*)(cw + tp * LDU + f0), b = *(const f32x4*)(cw + tp * LDU + f0 + 4), c = *(const f32x4*)(cw + tp * LDU + DFF + f0), d = *(const f32x4*)(cw + tp * LDU + DFF + f0 + 4);
#pragma unroll
            for (int j = 0; j < 4; ++j) { wg[tp][j] = a[j]; wg[tp][4 + j] = b[j]; wv[tp][j] = c[j]; wv[tp][4 + j] = d[j]; }
        }
        {
            const f32x4 a = *(const f32x4*)(cbias + f0), b = *(const f32x4*)(cbias + f0 + 4), c = *(const f32x4*)(cbias + DFF + f0), d = *(const f32x4*)(cbias + DFF + f0 + 4);
#pragma unroll
            for (int j = 0; j < 4; ++j) { bg[j] = a[j]; bg[4 + j] = b[j]; bv[j] = c[j]; bv[4 + j] = d[j]; }
        }
        float g2[8], g1[8], v2[8], v1[8];
        if ((r0 & (SEQ - 1)) == 0) {
#pragma unroll
            for (int j = 0; j < 8; ++j) { g2[j] = 0.f; g1[j] = 0.f; v2[j] = 0.f; v1[j] = 0.f; }
        } else {
            const bf16_t* p2 = up + (size_t)(r0 - 2) * LDU + f0; const bf16_t* p1 = p2 + LDU;
            unpack8(*(const u32x4*)p2, g2); unpack8(*(const u32x4*)(p2 + DFF), v2); unpack8(*(const u32x4*)p1, g1); unpack8(*(const u32x4*)(p1 + DFF), v1);
        }
#pragma unroll 4
        for (int rr = 0; rr < RS; ++rr) {
            const bf16_t* p0 = up + (size_t)(r0 + rr) * LDU + f0;
            float gc[8], vc[8]; unpack8(*(const u32x4*)p0, gc); unpack8(*(const u32x4*)(p0 + DFF), vc);
            float o[8];
#pragma unroll
            for (int j = 0; j < 8; ++j) {
                const float yg = bg[j] + wg[0][j] * g2[j] + wg[1][j] * g1[j] + wg[2][j] * gc[j];
                const float yv = bv[j] + wv[0][j] * v2[j] + wv[1][j] * v1[j] + wv[2][j] * vc[j];
                o[j] = silu(yg) * yv;
                g2[j] = g1[j]; g1[j] = gc[j]; v2[j] = v1[j]; v1[j] = vc[j];
            }
            u32x4 w; w.x = pk2(o[0], o[1]); w.y = pk2(o[2], o[3]); w.z = pk2(o[4], o[5]); w.w = pk2(o[6], o[7]);
            *(u32x4*)(act + (size_t)(r0 + rr) * DFF + f0) = w;
        }
    }
}

DI void ffn_fix_phase(const float* __restrict__ halo, const float* __restrict__ cw, const float* __restrict__ cb, bf16_t* __restrict__ act, int bx, int G, int wave_s) {
    const int gtid = bx * 512 + opaque_tid(wave_s), GT = G * 512;
    constexpr int FQ = DFF / 4, NIT = 56 * FQ;
    for (int it = gtid; it < NIT; it += GT) {
        const int f = (it % FQ) * 4, k = it / FQ, pm = (k / 7) * 8 + 1 + (k % 7);
        f32x4 yr[2][2];
#pragma unroll
        for (int bj = 0; bj < 2; ++bj) {
            const float* hp = halo + ((size_t)((pm - 1) * 2 + bj) * 4) * DFF + f; const float* hc = halo + ((size_t)(pm * 2 + bj) * 4) * DFF + f;
            const f32x4 a2 = *(const f32x4*)(hp + 2 * DFF), a1 = *(const f32x4*)(hp + 3 * DFF), c0 = *(const f32x4*)hc, c1 = *(const f32x4*)(hc + DFF);
            const int c = bj * DFF + f;
            const f32x4 w0 = *(const f32x4*)(cw + c), w1 = *(const f32x4*)(cw + 2 * DFF + c), w2 = *(const f32x4*)(cw + 4 * DFF + c), bb = *(const f32x4*)(cb + c);
            yr[bj][0] = bb + w0 * a2 + w1 * a1 + w2 * c0; yr[bj][1] = bb + w0 * a1 + w1 * c0 + w2 * c1;
        }
#pragma unroll
        for (int rr = 0; rr < 2; ++rr) { u32x2 w; w.x = pk2(silu(yr[0][rr][0]) * yr[1][rr][0], silu(yr[0][rr][1]) * yr[1][rr][1]); w.y = pk2(silu(yr[0][rr][2]) * yr[1][rr][2], silu(yr[0][rr][3]) * yr[1][rr][3]);
            *(u32x2*)(act + (size_t)(pm * 256 + rr) * DFF + f) = w; }
    }
}

#define XB_XCNT(j)  (256  + 64 * (j))
#define XB_XSUB(j)  (1280 + 64 * (j))
#define XB_XGEN(j)  (2304 + 64 * (j))
#define XB_TOP      3328
#define XB_TOPGEN   3392
#define XCD_BAR_WORDS 3456
DI unsigned xb_ld(unsigned* p) { return __hip_atomic_load(p, __ATOMIC_RELAXED, __HIP_MEMORY_SCOPE_AGENT); }
DI unsigned xb_add(unsigned* p, unsigned v) { return __hip_atomic_fetch_add(p, v, __ATOMIC_RELAXED, __HIP_MEMORY_SCOPE_AGENT); }
DI unsigned xb_xcc_id() { return (unsigned)__builtin_amdgcn_s_getreg((3 << 11) | 20) & 0xFu; }
#define XB_SPIN(cond) do { unsigned _sp = 0; while (cond) { __builtin_amdgcn_s_sleep(1); if (++_sp > (1u << 24)) break; } } while (0)
DI void xcd_barrier(unsigned* bar, volatile LAS unsigned* st, int tid) {
    asm volatile("s_waitcnt vmcnt(0) lgkmcnt(0)" ::: "memory");
    __syncthreads();
    if (tid == 0) {
        const unsigned x = xb_xcc_id();
        unsigned nloc = st[0], nx = st[1];
        if (nloc == 0u) {
            const unsigned G = gridDim.x; unsigned sp = 0;
            for (;;) {
                unsigned sum = 0u, cnt = 0u, mine = 0u;
#pragma unroll
                for (unsigned j = 0; j < 16; ++j) { const unsigned c = xb_ld(&bar[XB_XCNT(j)]); sum += c; cnt += (c > 0u) ? 1u : 0u; mine = (j == x) ? c : mine; }
                nloc = mine > 0u ? mine : 1u; nx = cnt > 0u ? cnt : 1u;
                if (sum == G) break;
                __builtin_amdgcn_s_sleep(1); if (++sp > (1u << 22)) break;
            }
            st[0] = nloc; st[1] = nx;
        }
        const unsigned old = xb_add(&bar[XB_XSUB(x)], 1u);
        const unsigned gen = old / nloc;
        if (old + 1u == (gen + 1u) * nloc) {
            __builtin_amdgcn_fence(__ATOMIC_RELEASE, "agent");
            asm volatile("s_waitcnt vmcnt(0)" ::: "memory");
            const unsigned og = xb_add(&bar[XB_TOP], 1u);
            const unsigned tg = og / nx;
            if (og + 1u == (tg + 1u) * nx) xb_add(&bar[XB_TOPGEN], 1u);
            else XB_SPIN(xb_ld(&bar[XB_TOPGEN]) == tg);
            __builtin_amdgcn_fence(__ATOMIC_ACQUIRE, "agent");
            xb_add(&bar[XB_XGEN(x)], 1u);
            asm volatile("s_waitcnt vmcnt(0)" ::: "memory");
        } else {
            XB_SPIN(xb_ld(&bar[XB_XGEN(x)]) == gen);
            __builtin_amdgcn_fence(__ATOMIC_ACQUIRE, "agent");
            asm volatile("s_waitcnt vmcnt(0)" ::: "memory");
        }
    }
    __syncthreads();
}

#define SLACK_IDS(nwg_) const int rounds_ = ((nwg_) + G - 1) / G, nfull_ = (nwg_) - (rounds_ - 1) * G; const bool all_ = nfull_ == G; \
        const bool mine_ = all_ || bx >= nfull_; const int tid_ = opaque_tid(wave_s), lane_ = tid_ & 63, wv_ = tid_ >> 6; \
        const int sgw_ = (all_ ? bx : bx - nfull_) * 8 + wv_, sngw_ = (all_ ? G : G - nfull_) * 8; LAS float* sscr_ = (LAS float*)(lds + wv_ * 8704)
#ifndef REP_ATT
#define REP_ATT 1
#endif
#ifndef REP_CACT
#define REP_CACT 1
#endif
#ifndef REP_CONV
#define REP_CONV 1
#endif
#ifndef REP_NORM
#define REP_NORM 1
#endif
struct Args { const float* in[30]; float* out; unsigned char* ws; };
constexpr int LDS_BYTES = 131072 + 64 + 8192 + 8192 + 8192;

__global__ void __launch_bounds__(512, 2) mega_fwd(Args args) {
    extern __shared__ __attribute__((aligned(16))) unsigned char lds_raw[];
    LAS unsigned char* lds = (LAS unsigned char*)lds_raw;
    cg::grid_group grid = cg::this_grid();
#define GSYNC_LIB() do { asm volatile("s_waitcnt vmcnt(0) lgkmcnt(0)" ::: "memory"); grid.sync(); } while (0)
#define GSYNC() xcd_barrier((unsigned*)args.ws, (volatile LAS unsigned*)(lds + 131072), opaque_tid(wave_s))
    const int G = gridDim.x, bx = blockIdx.x;
    const int wave_s = __builtin_amdgcn_readfirstlane((int)(threadIdx.x >> 6));
    const int vcu = (G % 8 == 0) ? (bx % 8) * (G / 8) + bx / 8 : bx;
    unsigned char* ws = args.ws;
    float* out = args.out;
    const float* x = args.in[0]; const int* positions = (const int*)args.in[1];
    bf16_t* XB = (bf16_t*)(ws + WS_XB); unsigned char* BIG = ws + WS_BIG; unsigned char* ACT = ws + WS_ACT;
    float* flog = (float*)(ws + WS_FLOG); float* cum = (float*)(ws + WS_CUM); float* krope = (float*)(ws + WS_KROPE); float* rcs = (float*)(ws + WS_RCS); float* rsn = (float*)(ws + WS_RSN);

    if (threadIdx.x < 2) ((volatile LAS unsigned*)(lds + 131072))[threadIdx.x] = 0u;
    if (blockIdx.x == 0) for (int i = threadIdx.x; i < XCD_BAR_WORDS; i += 512) ((unsigned*)args.ws)[i] = 0u;
    {
        const int tid = opaque_tid(wave_s), lane = tid & 63, wave = tid >> 6, gw = vcu * 8 + wave, NGW = G * 8;
        LAS float* scr = (LAS float*)(lds + wave * 8704);
        for (int i = bx * 512 + tid; i < M_TOK * 32; i += G * 512) {
            const float ang = (float)positions[i >> 5] * exp2f(-(float)(i & 31) * (13.287712379549449f / 32.f));
            const double ad = (double)ang; const double nrev = rint(ad * 0.15915494309189535); const float red = (float)(ad - nrev * 6.283185307179586);
            rcs[i] = __cosf(red); rsn[i] = __sinf(red);
        }
#define CONV(src, gain, dstoff, K, N, Npad) convert_matrix(src, gain, (bf16_t*)(ws + (dstoff)), K, N, Npad, scr, gw, NGW, lane)
        for (int rep_ = 0; rep_ < REP_CONV; ++rep_) {
        CONV(args.in[4], args.in[2] + 0 * DM, W_FOX_IN, 2048, 6160, 6400);
        CONV(args.in[8], nullptr, W_FOX_OUT, 2048, 2048, 2048);
        CONV(args.in[9], args.in[2] + 1 * DM, W_MLA_IN, 2048, 1088, 1280);
        CONV(args.in[12], args.in[10], W_MLA_QB, 512, 3072, 3072);
        CONV(args.in[13], args.in[11], W_MLA_KVB, 512, 4096, 4096);
        CONV(args.in[16], nullptr, W_MLA_OUT, 2048, 2048, 2048);
        for (int l = 0; l < 4; ++l) {
            convert_matrix(args.in[26] + (size_t)l * 2048 * 11264, args.in[3] + l * DM, (bf16_t*)(ws + W_UP + (size_t)l * 44 * MiB), 2048, 11264, 11264, scr, gw, NGW, lane, true);
            if (l < 3) CONV(args.in[29] + (size_t)l * 5632 * 2048, nullptr, W_DOWN + (size_t)l * 22 * MiB, 5632, 2048, 2048);
        }
        }
#undef CONV
        norm_phase(x, XB, (float*)(ws + WS_RSH), vcu, G, wave_s);
    }
    GSYNC_LIB();
    if (threadIdx.x == 0) (void)xb_add(&((unsigned*)args.ws)[XB_XCNT(xb_xcc_id())], 1u);

    for (int layer_ = 0; layer_ < 4; ++layer_) {
        const int layer = opaque_s(layer_);
        unsigned char* ws = opaque_p(args.ws); float* out = opaque_p(args.out);
        const int G = opaque_s((int)gridDim.x), bx = opaque_s((int)blockIdx.x);
        const int vcu = (G % 8 == 0) ? (bx % 8) * (G / 8) + bx / 8 : bx;
        bf16_t* XB = (bf16_t*)(ws + WS_XB); unsigned char* BIG = ws + WS_BIG; unsigned char* ACT = ws + WS_ACT;
            float* flog = (float*)(ws + WS_FLOG); float* cum = (float*)(ws + WS_CUM); float* krope = (float*)(ws + WS_KROPE); float* rcs = (float*)(ws + WS_RCS); float* rsn = (float*)(ws + WS_RSN); float* rsp = (float*)(ws + WS_RSP); float* rssgu = (float*)(ws + WS_RSSGU); float* rsh = (float*)(ws + WS_RSH);
        bf16_t* Obuf = (bf16_t*)ACT;
        const bf16_t* Wout;
        if (layer == 0) {
            bf16_t* QKV = (bf16_t*)BIG; bf16_t* KN = (bf16_t*)(BIG + 192 * MiB); bf16_t* VT = (bf16_t*)(BIG + 288 * MiB);
            { pg8::Gemm g{XB, DM, (const bf16_t*)(ws + W_FOX_IN), DM, M_TOK, 6400, DM}; pg8::StaticOrder S; S.init(M_TOK, 6400, G, bx);
              const int pmb_ = (bx & 7) * 8; pg8::rstd_tab_build(rsh, pmb_, (LAS float*)(lds + 131072 + 64 + 8192), opaque_tid(wave_s));
              pg8::EpiQKV<true> E{QKV, KN, args.in[7], flog, rsh, (LAS float*)(lds + 131072 + 64), (LAS float*)(lds + 131072 + 64 + 8192), pmb_}; pg8::gemm_phase(lds, g, S, E, wave_s); }
            { SLACK_IDS(64 * 25);
              if (mine_) { convert_matrix(args.in[17], args.in[2] + 2 * DM, (bf16_t*)(ws + W_SB_IN), 2048, 6144, 6144, sscr_, sgw_, sngw_, lane_);
                           convert_matrix(args.in[21], args.in[2] + 3 * DM, (bf16_t*)(ws + W_SGU_IN), 2048, 4096, 4096, sscr_, sgw_, sngw_, lane_); } }
            GSYNC();
            for (int rep_ = 0; rep_ < REP_ATT; ++rep_) { kvprep_phase<0>(lds, QKV, KN, VT, args.in[7], flog, args.in[5], cum, nullptr, nullptr, nullptr, vcu, G, wave_s); __syncthreads(); }
            GSYNC();
            for (int rep_ = 0; rep_ < REP_ATT; ++rep_) { attn_phase<0>(lds, QKV, 6144, 128, KN, QKV + 4096, 6144, 128, cum, args.in[6], args.in[7], nullptr, Obuf, vcu, G, wave_s); __syncthreads(); }
            Wout = (const bf16_t*)(ws + W_FOX_OUT);
        } else if (layer == 1) {
            bf16_t* Cb = (bf16_t*)(ACT + 128 * MiB); bf16_t* Qb = (bf16_t*)BIG; bf16_t* KN = (bf16_t*)(BIG + 96 * MiB); bf16_t* VT = nullptr; bf16_t* KV = (bf16_t*)(BIG + 192 * MiB);
            { pg8::Gemm g{XB, DM, (const bf16_t*)(ws + W_MLA_IN), DM, M_TOK, 1280, DM}; pg8::StaticOrder S; S.init(M_TOK, 1280, G, bx);
              const int pmb_ = (bx & 7) * 8; pg8::rstd_tab_build(rsh, pmb_, (LAS float*)(lds + 131072 + 64 + 8192), opaque_tid(wave_s));
              pg8::EpiMlaIn E{Cb, rsp, krope, rsh, (LAS float*)(lds + 131072 + 64 + 8192), pmb_}; pg8::gemm_phase(lds, g, S, E, wave_s); }
            { SLACK_IDS(64 * 5);
              if (mine_) { convert_matrix(args.in[20], nullptr, (bf16_t*)(ws + W_SB_OUT), 2048, 2048, 2048, sscr_, sgw_, sngw_, lane_);
                           convert_matrix(args.in[25], nullptr, (bf16_t*)(ws + W_SGU_OUT), 2048, 2048, 2048, sscr_, sgw_, sngw_, lane_);
                           convert_matrix(args.in[29] + (size_t)3 * 5632 * 2048, nullptr, (bf16_t*)(ws + W_DOWN + (size_t)3 * 22 * MiB), 5632, 2048, 2048, sscr_, sgw_, sngw_, lane_); } }
            GSYNC();
            { pg8::Gemm g{Cb, 1024, (const bf16_t*)(ws + W_MLA_QB), 512, M_TOK, 3072, 512}; pg8::StaticOrder S; S.init(M_TOK, 3072, G, bx);
              pg8::rstd512_tab_build(rsp, (bx & 7) * 8, (LAS float*)(lds + 131072 + 64 + 8192), (LAS float*)(lds + 131072 + 64 + 16384), opaque_tid(wave_s));
              pg8::EpiStore<0, 1, false> E{Qb, 3072, rsp, nullptr, 0, (LAS float*)(lds + 131072 + 64 + 8192), (bx & 7) * 8}; pg8::gemm_phase(lds, g, S, E, wave_s); }
            { pg8::Gemm g{Cb + 512, 1024, (const bf16_t*)(ws + W_MLA_KVB), 512, M_TOK, 4096, 512}; pg8::StaticOrder S; S.init(M_TOK, 4096, G, bx);
              pg8::EpiMlaKV E{KV, KN, args.in[15], rsp + 8, (LAS float*)(lds + 131072 + 64), (LAS float*)(lds + 131072 + 64 + 16384), (bx & 7) * 8}; pg8::gemm_phase(lds, g, S, E, wave_s); }
            kvprep_phase<1>(lds, KV, KN, VT, args.in[15], nullptr, nullptr, nullptr, krope, rcs, rsn, vcu, G, wave_s);
            GSYNC();
            for (int rep_ = 0; rep_ < REP_ATT; ++rep_) { attn_phase<1>(lds, Qb, 3072, 192, KN, KV + 128, 4096, 256, nullptr, args.in[14], rcs, rsn, Obuf, vcu, G, wave_s); __syncthreads(); }
            Wout = (const bf16_t*)(ws + W_MLA_OUT);
        } else if (layer == 2) {
            bf16_t* QKV = (bf16_t*)BIG; bf16_t* KN = (bf16_t*)(BIG + 192 * MiB); bf16_t* VT = (bf16_t*)(BIG + 288 * MiB);
            { pg8::Gemm g{XB, DM, (const bf16_t*)(ws + W_SB_IN), DM, M_TOK, 6144, DM}; pg8::StaticOrder S; S.init(M_TOK, 6144, G, bx);
              const int pmb_ = (bx & 7) * 8; pg8::rstd_tab_build(rsh, pmb_, (LAS float*)(lds + 131072 + 64 + 8192), opaque_tid(wave_s));
              pg8::EpiQKV<false> E{QKV, KN, args.in[19], nullptr, rsh, (LAS float*)(lds + 131072 + 64), (LAS float*)(lds + 131072 + 64 + 8192), pmb_}; pg8::gemm_phase(lds, g, S, E, wave_s); }
            GSYNC();
            for (int rep_ = 0; rep_ < REP_ATT; ++rep_) { attn_phase<2>(lds, QKV, 6144, 128, KN, QKV + 4096, 6144, 128, nullptr, args.in[18], nullptr, nullptr, Obuf, vcu, G, wave_s); __syncthreads(); }
            Wout = (const bf16_t*)(ws + W_SB_OUT);
        } else {
            bf16_t* UV = (bf16_t*)BIG;
            { pg8::Gemm g{XB, DM, (const bf16_t*)(ws + W_SGU_IN), DM, M_TOK, 4096, DM}; pg8::StaticOrder S; S.init(M_TOK, 4096, G, bx);
              const int pmb_ = (bx & 7) * 8; pg8::rstd_tab_build(rsh, pmb_, (LAS float*)(lds + 131072 + 64 + 8192), opaque_tid(wave_s));
              pg8::EpiStore<1, 2, true> E{UV, 4096, rsh, rssgu, 8, (LAS float*)(lds + 131072 + 64 + 8192), pmb_}; pg8::gemm_phase(lds, g, S, E, wave_s); }
            GSYNC();
            for (int rep_ = 0; rep_ < REP_ATT; ++rep_) { sgu_phase(lds, UV, rssgu, args.in[22], args.in[23], args.in[24], Obuf, vcu, G, wave_s); __syncthreads(); }
            Wout = (const bf16_t*)(ws + W_SGU_OUT);
        }
        GSYNC();
        { pg8::Gemm g{Obuf, DM, Wout, DM, M_TOK, DM, DM}; pg8::StaticOrder S; S.init(M_TOK, DM, G, bx);
          if (layer == 0) { pg8::EpiResid<true, false> E{x, out, XB, rsh}; pg8::gemm_phase(lds, g, S, E, wave_s); }
          else { pg8::EpiResid<false, false> E{x, out, XB, rsh}; pg8::gemm_phase(lds, g, S, E, wave_s); } }
        GSYNC();
        bf16_t* AC = (bf16_t*)ACT; float* halo = (float*)(ws + WS_HALO);
        const float* cwl = args.in[27] + (size_t)layer * 3 * 2 * DFF; const float* cbl = args.in[28] + (size_t)layer * 2 * DFF;
        { pg8::Gemm g{XB, DM, (const bf16_t*)(ws + W_UP + (size_t)layer * 44 * MiB), DM, M_TOK, 2 * DFF, DM}; pg8::StaticOrder S; S.init(M_TOK, 2 * DFF, G, bx);
          const int pmb_ = (bx & 7) * 8; pg8::rstd_tab_build(rsh, pmb_, (LAS float*)(lds + 131072 + 64 + 8192), opaque_tid(wave_s));
              pg8::EpiUpConv E{AC, rsh, cwl, cbl, halo, (LAS float*)(lds + 131072 + 64), (LAS float*)(lds + 131072 + 64 + 8192), pmb_}; pg8::gemm_phase(lds, g, S, E, wave_s); }
        GSYNC();
        ffn_fix_phase(halo, cwl, cbl, AC, bx, G, wave_s);
        GSYNC();
        { pg8::Gemm g{AC, DFF, (const bf16_t*)(ws + W_DOWN + (size_t)layer * 22 * MiB), DFF, M_TOK, DM, DFF}; pg8::StaticOrder S; S.init(M_TOK, DM, G, bx);
          if (layer < 3) { pg8::EpiResid<false, false> E{x, out, XB, rsh}; pg8::gemm_phase(lds, g, S, E, wave_s); }
          else { pg8::EpiResid<false, true> E{x, out, XB, rsh}; pg8::gemm_phase(lds, g, S, E, wave_s); } }
        if (layer < 3) GSYNC();
    }
}

extern "C" void kernel_launch(void* const* d_in, const int* in_sizes, int n_in, void* d_out, int out_size, void* d_ws, size_t ws_size, hipStream_t stream) {
    static int grid = 0;
    if (grid == 0) {
        if (n_in != 30 || ws_size < WS_END) { fprintf(stderr, "kernel_launch: unexpected problem (n_in %d, ws %zu)\n", n_in, ws_size); grid = -1; return; }
        int dev = 0, cus = 0, per_cu = 0;
        hipGetDevice(&dev);
        hipDeviceGetAttribute(&cus, hipDeviceAttributeMultiprocessorCount, dev);
        hipFuncSetAttribute((const void*)mega_fwd, hipFuncAttributeMaxDynamicSharedMemorySize, LDS_BYTES);
        hipOccupancyMaxActiveBlocksPerMultiprocessor(&per_cu, (const void*)mega_fwd, 512, LDS_BYTES);
        if (per_cu < 1) { fprintf(stderr, "kernel_launch: occupancy query returned %d\n", per_cu); per_cu = 1; }
        grid = cus * per_cu;
    }
    if (grid < 0) return;
    Args a{};
    for (int i = 0; i < 30; ++i) a.in[i] = (const float*)d_in[i];
    a.out = (float*)d_out; a.ws = (unsigned char*)d_ws;
    void* kargs[] = {&a};
    hipError_t e = hipLaunchCooperativeKernel((const void*)mega_fwd, dim3(grid), dim3(512), kargs, LDS_BYTES, stream);
    if (e != hipSuccess) fprintf(stderr, "cooperative launch failed: %s (grid %d)\n", hipGetErrorString(e), grid);
}
```

```cpp
#include <hip/hip_runtime.h>
#include <hip/hip_cooperative_groups.h>
#include <cstdio>
#include <cstdint>
namespace cg = cooperative_groups;

#define DI __device__ __forceinline__
#define LAS __attribute__((address_space(3)))
typedef unsigned short bf16_t;
typedef short bf16x8 __attribute__((ext_vector_type(8)));
typedef float f32x4 __attribute__((ext_vector_type(4)));
typedef float f32x2 __attribute__((ext_vector_type(2)));
typedef float f32x16 __attribute__((ext_vector_type(16)));
typedef unsigned u32x4 __attribute__((ext_vector_type(4)));
typedef unsigned u32x2 __attribute__((ext_vector_type(2)));
typedef __bf16 bf16x2_t __attribute__((ext_vector_type(2)));
typedef short s16x4 __attribute__((ext_vector_type(4)));

constexpr int M_TOK = 16384, DM = 2048, SEQ = 2048, NH = 16, DFF = 5632;
constexpr float EPS = 1e-6f;
constexpr float LOG2E = 1.4426950408889634f;

DI unsigned pk2(float lo, float hi) { f32x2 v = {lo, hi}; bf16x2_t b = __builtin_convertvector(v, bf16x2_t); return __builtin_bit_cast(unsigned, b); }
DI float bf_lo(unsigned w) { return __uint_as_float(w << 16); }
DI float bf_hi(unsigned w) { return __uint_as_float(w & 0xffff0000u); }
DI float wave_sum(float v) {
#pragma unroll
    for (int o = 1; o < 64; o <<= 1) v += __shfl_xor(v, o);
    return v;
}
DI float fast_rcp(float x) { return __builtin_amdgcn_rcpf(x); }
DI float fast_exp2(float x) { return __builtin_amdgcn_exp2f(x); }
DI float fast_log2(float x) { return __builtin_amdgcn_logf(x); }
DI float gelu_tanh(float x) { const float u = 0.7978845608028654f * (x + 0.044715f * x * x * x); return x * fast_rcp(1.f + fast_exp2(-2.f * LOG2E * u)); }
DI float silu(float x) { return x * fast_rcp(1.f + fast_exp2(-LOG2E * x)); }
#define LDS_WAIT() asm volatile("s_waitcnt lgkmcnt(0)" ::: "memory")
DI int opaque_tid(int wave_s) { unsigned m = ~0u; asm volatile("" : "+s"(m)); int l = (int)__builtin_amdgcn_mbcnt_hi(m, __builtin_amdgcn_mbcnt_lo(m, 0u)); asm volatile("" : "+v"(l)); asm volatile("" : "+s"(wave_s)); return (wave_s << 6) | l; }
DI int opaque_s(int v) { asm volatile("" : "+s"(v)); return v; }
template <class T> DI T* opaque_p(T* p) { asm volatile("" : "+s"(p)); return p; }

namespace pg8 {
constexpr int BM = 256, BK = 64, HALF = 128, HTB = HALF * BK * 2, STAGE_BYTES = 8 * HTB, NXCD = 8, WGM = 8;
__host__ __device__ __forceinline__ int lds_byte(int r, int c) { const int st = (r >> 4) * 2 + (c >> 5), rr = r & 15, cc = c & 31, ob = rr * 64 + cc * 2; return st * 1024 + (ob ^ (((ob >> 9) & 1) << 5)); }
__host__ __device__ __forceinline__ void stage_rc(int b, int& R, int& C) { const int st = b / 1024, sb = b % 1024, swz = sb ^ (((sb >> 9) & 1) << 5); R = (st >> 1) * 16 + swz / 64; C = (st & 1) * 32 + (swz % 64) / 2; }
__host__ __device__ __forceinline__ int perm32(int rho) { const int n = rho >> 4, i = rho & 15; return 8 * (i >> 2) + 4 * n + (i & 3); }

struct Unit { int pm, pn; };
struct Gemm { const bf16_t* A; int lda; const bf16_t* Bt; int ldb; int M, N, K; };

struct StaticOrder {
    int nM, nN, nwg, G, c;
    __host__ __device__ void init(int M, int N, int G_, int c_) { nM = M / BM; nN = N / BM; nwg = nM * nN; G = G_; c = c_; }
    __host__ __device__ bool next(int i, Unit& u) const {
        const long L = (long)i * G + c; if (L >= nwg) return false;
        int wgid = (int)L; { const int q = nwg / NXCD, r = nwg % NXCD, xcd = wgid % NXCD, off = wgid / NXCD; wgid = (xcd < r ? xcd * (q + 1) : r * (q + 1) + (xcd - r) * q) + off; }
        const int nig = WGM * nN, gid = wgid / nig, fm = gid * WGM, gsz = (nM - fm) < WGM ? (nM - fm) : WGM;
        u.pm = fm + ((wgid % nig) % gsz); u.pn = (wgid % nig) / gsz; return true;
    }
};

typedef f32x4 Acc[2][2][4][2];

DI float hrstd(const float* rsh, int r, int fq) {
    const char* rp = (const char*)rsh + (unsigned)((r * 32 + fq * 8) * 4);
    const f32x4 pa = *(const f32x4*)rp, pb = *(const f32x4*)(rp + 16);
    float s = ((pa[0] + pa[1]) + (pa[2] + pa[3])) + ((pb[0] + pb[1]) + (pb[2] + pb[3]));
    s += __shfl_xor(s, 16); s += __shfl_xor(s, 32);
    return __builtin_amdgcn_rsqf(s * (1.f / DM) + EPS);
}
DI float hrstd_t(const float* rsh, LAS const float* tab, int pm_base, int pm, int rl, int fq) {
    if ((unsigned)(pm - pm_base) < 8u) return tab[(pm - pm_base) * 256 + rl];
    return hrstd(rsh, pm * BM + rl, fq);
}
DI void rstd_tab_build(const float* rsh, int pm_base, LAS float* tab, int tid) {
#pragma unroll
    for (int k = 0; k < 4; ++k) {
        const int row = tid + 512 * k; const f32x4* p = (const f32x4*)(rsh + (size_t)(pm_base * BM + row) * 32);
        f32x4 a = p[0] + p[1]; f32x4 b = p[2] + p[3]; f32x4 c = p[4] + p[5]; f32x4 d = p[6] + p[7];
        a = (a + b) + (c + d);
        tab[row] = __builtin_amdgcn_rsqf(((a[0] + a[1]) + (a[2] + a[3])) * (1.f / DM) + EPS);
    }
    __syncthreads();
}
DI void rstd512_tab_build(const float* rsp, int pm_base, LAS float* tq, LAS float* tkv, int tid) {
#pragma unroll
    for (int k = 0; k < 4; ++k) {
        const int row = tid + 512 * k; const f32x4* p = (const f32x4*)(rsp + (size_t)(pm_base * BM + row) * 16);
        const f32x4 a = p[0] + p[1], b = p[2] + p[3];
        tq[row] = __builtin_amdgcn_rsqf(((a[0] + a[1]) + (a[2] + a[3])) * (1.f / 512.f) + EPS);
        tkv[row] = __builtin_amdgcn_rsqf(((b[0] + b[1]) + (b[2] + b[3])) * (1.f / 512.f) + EPS);
    }
    __syncthreads();
}
template <int ACT, int SCALE, bool ACC> struct EpiStore {
    static constexpr bool PERM = true;
    bf16_t* O; int ldc; const float* rs_in; float* rs_out; int acc_pn_lo; LAS const float* tab; int pm_base;
    DI void operator()(const Acc& acc, const Unit& u, int wr, int wc, int fr, int fq) const {
        const int row0 = u.pm * BM + wr * 64 + fr, col0 = u.pn * BM + wc * 32 + 8 * fq;
#pragma unroll
        for (int ai = 0; ai < 2; ++ai)
#pragma unroll
            for (int m = 0; m < 4; ++m) {
                const int r = row0 + ai * HALF + m * 16;
                float sc = 1.f; if (SCALE == 2) sc = hrstd_t(rs_in, tab, pm_base, u.pm, wr * 64 + fr + ai * HALF + m * 16, fq);
                if (SCALE == 1) {
                    if ((unsigned)(u.pm - pm_base) < 8u) sc = tab[(u.pm - pm_base) * 256 + wr * 64 + fr + ai * HALF + m * 16];
                    else { const f32x4 pa = *(const f32x4*)(rs_in + (size_t)r * 16), pb = *(const f32x4*)(rs_in + (size_t)r * 16 + 4);
                        sc = __builtin_amdgcn_rsqf((((pa[0] + pa[1]) + (pa[2] + pa[3])) + ((pb[0] + pb[1]) + (pb[2] + pb[3]))) * (1.f / 512.f) + EPS); } }
                float ss = 0.f;
                bf16_t* rowp = O + (size_t)r * ldc + col0;
#pragma unroll
                for (int bj = 0; bj < 2; ++bj) {
                    f32x4 v0 = acc[ai][bj][m][0], v1 = acc[ai][bj][m][1];
                    if (SCALE) { v0 = v0 * sc; v1 = v1 * sc; }
                    if (ACT == 1) {
#pragma unroll
                        for (int j = 0; j < 4; ++j) { v0[j] = gelu_tanh(v0[j]); v1[j] = gelu_tanh(v1[j]); }
                    }
                    if (ACC) ss += (v0[0] * v0[0] + v0[1] * v0[1]) + (v0[2] * v0[2] + v0[3] * v0[3]) + (v1[0] * v1[0] + v1[1] * v1[1]) + (v1[2] * v1[2] + v1[3] * v1[3]);
                    u32x4 w; w.x = pk2(v0[0], v0[1]); w.y = pk2(v0[2], v0[3]); w.z = pk2(v1[0], v1[1]); w.w = pk2(v1[2], v1[3]);
                    *(u32x4*)(rowp + bj * HALF) = w;
                }
                if (ACC) { if (u.pn >= acc_pn_lo) { ss += __shfl_xor(ss, 16); ss += __shfl_xor(ss, 32); if (fq == 0) rs_out[(size_t)r * 32 + (u.pn - acc_pn_lo) * 4 + wc] = ss; } }
            }
    }
};
template <int DQK_PITCH, int BJ_LO, int BJ_HI, class F>
DI void knorm_store(F v, bf16_t* Kn, const float* kgain, int head0, int head_bj_stride, const Unit& u, int wr, int wc, int fr, int fq, LAS float* xl) {
    const int rl0 = wr * 64 + fr;
#pragma unroll
    for (int ai = 0; ai < 2; ++ai)
#pragma unroll
        for (int m = 0; m < 4; ++m) { const int rl = ai * HALF + rl0 + m * 16;
#pragma unroll
            for (int bj = BJ_LO; bj < BJ_HI; ++bj) { const f32x4 v0 = v(ai, m, bj, 0), v1 = v(ai, m, bj, 1);
                float ss = (v0[0] * v0[0] + v0[1] * v0[1]) + (v0[2] * v0[2] + v0[3] * v0[3]) + (v1[0] * v1[0] + v1[1] * v1[1]) + (v1[2] * v1[2] + v1[3] * v1[3]);
                ss += __shfl_xor(ss, 16); ss += __shfl_xor(ss, 32); if (fq == 0) xl[(rl * 2 + bj) * 4 + wc] = ss; } }
    asm volatile("s_waitcnt lgkmcnt(0)" ::: "memory"); __builtin_amdgcn_s_barrier(); asm volatile("" ::: "memory");
    const f32x4 g0 = *(const f32x4*)(kgain + wc * 32 + 8 * fq), g1 = *(const f32x4*)(kgain + wc * 32 + 8 * fq + 4);
#pragma unroll
    for (int ai = 0; ai < 2; ++ai)
#pragma unroll
        for (int m = 0; m < 4; ++m) { const int rl = ai * HALF + rl0 + m * 16, row = u.pm * BM + rl, b = row >> 11, sq = row & (SEQ - 1);
#pragma unroll
            for (int bj = BJ_LO; bj < BJ_HI; ++bj) { const f32x4 pt = *(const LAS f32x4*)(xl + (rl * 2 + bj) * 4);
                const float r = __builtin_amdgcn_rsqf(((pt[0] + pt[1]) + (pt[2] + pt[3])) * (1.f / 128.f) + EPS);
                const f32x4 v0 = v(ai, m, bj, 0) * r * g0, v1 = v(ai, m, bj, 1) * r * g1;
                u32x4 w; w.x = pk2(v0[0], v0[1]); w.y = pk2(v0[2], v0[3]); w.z = pk2(v1[0], v1[1]); w.w = pk2(v1[2], v1[3]);
                *(u32x4*)(Kn + ((size_t)(b * 16 + head0 + bj * head_bj_stride) * SEQ + sq) * DQK_PITCH + wc * 32 + 8 * fq) = w; } }
}
template <bool FOX> struct EpiQKV {
    static constexpr bool PERM = true;
    bf16_t* O; bf16_t* Kn; const float* kgain; float* flog; const float* rsh; LAS float* xl; LAS const float* tab; int pm_base;
    DI void operator()(const Acc& acc, const Unit& u, int wr, int wc, int fr, int fq) const {
        const int row0 = u.pm * BM + wr * 64 + fr;
        float sc[2][4];
#pragma unroll
        for (int ai = 0; ai < 2; ++ai)
#pragma unroll
            for (int m = 0; m < 4; ++m) sc[ai][m] = hrstd_t(rsh, tab, pm_base, u.pm, wr * 64 + fr + ai * HALF + m * 16, fq);
        if (u.pn >= 8 && u.pn < 16) {
            knorm_store<128, 0, 2>([&](int ai, int m, int bj, int n) { return acc[ai][bj][m][n] * sc[ai][m]; }, Kn, kgain, (u.pn - 8) * 2, 1, u, wr, wc, fr, fq, xl);
        } else if (!FOX || u.pn < 24) {
            const int col0 = u.pn * BM + wc * 32 + 8 * fq;
#pragma unroll
            for (int ai = 0; ai < 2; ++ai)
#pragma unroll
                for (int m = 0; m < 4; ++m) {
                    bf16_t* rowp = O + (size_t)(row0 + ai * HALF + m * 16) * 6144 + col0;
#pragma unroll
                    for (int bj = 0; bj < 2; ++bj) {
                        const f32x4 v0 = acc[ai][bj][m][0] * sc[ai][m], v1 = acc[ai][bj][m][1] * sc[ai][m];
                        u32x4 w; w.x = pk2(v0[0], v0[1]); w.y = pk2(v0[2], v0[3]); w.z = pk2(v1[0], v1[1]); w.w = pk2(v1[2], v1[3]);
                        *(u32x4*)(rowp + bj * HALF) = w;
                    }
                }
        } else if (wc == 0 && fq < 2) {
#pragma unroll
            for (int ai = 0; ai < 2; ++ai)
#pragma unroll
                for (int m = 0; m < 4; ++m) {
                    float* rowp = flog + (size_t)(row0 + ai * HALF + m * 16) * 16 + 8 * fq;
                    *(f32x4*)(rowp) = acc[ai][0][m][0] * sc[ai][m]; *(f32x4*)(rowp + 4) = acc[ai][0][m][1] * sc[ai][m];
                }
        }
    }
};
struct EpiMlaKV {
    static constexpr bool PERM = true;
    bf16_t* KV; bf16_t* Kn; const float* kgain; const float* rs_in; LAS float* xl; LAS const float* tab; int pm_base;
    DI void operator()(const Acc& acc, const Unit& u, int wr, int wc, int fr, int fq) const {
        const int row0 = u.pm * BM + wr * 64 + fr;
        float sc[2][4];
#pragma unroll
        for (int ai = 0; ai < 2; ++ai)
#pragma unroll
            for (int m = 0; m < 4; ++m) { const int r = row0 + ai * HALF + m * 16;
                if ((unsigned)(u.pm - pm_base) < 8u) sc[ai][m] = tab[(u.pm - pm_base) * 256 + wr * 64 + fr + ai * HALF + m * 16];
                else { const f32x4 pa = *(const f32x4*)(rs_in + (size_t)r * 16), pb = *(const f32x4*)(rs_in + (size_t)r * 16 + 4);
                    sc[ai][m] = __builtin_amdgcn_rsqf((((pa[0] + pa[1]) + (pa[2] + pa[3])) + ((pb[0] + pb[1]) + (pb[2] + pb[3]))) * (1.f / 512.f) + EPS); } }
#pragma unroll
        for (int ai = 0; ai < 2; ++ai)
#pragma unroll
            for (int m = 0; m < 4; ++m) {
                const f32x4 v0 = acc[ai][1][m][0] * sc[ai][m], v1 = acc[ai][1][m][1] * sc[ai][m];
                u32x4 w; w.x = pk2(v0[0], v0[1]); w.y = pk2(v0[2], v0[3]); w.z = pk2(v1[0], v1[1]); w.w = pk2(v1[2], v1[3]);
                *(u32x4*)(KV + (size_t)(row0 + ai * HALF + m * 16) * 4096 + u.pn * BM + HALF + wc * 32 + 8 * fq) = w;
            }
        knorm_store<192, 0, 1>([&](int ai, int m, int bj, int n) { return acc[ai][bj][m][n] * sc[ai][m]; }, Kn, kgain, u.pn, 0, u, wr, wc, fr, fq, xl);
    }
};
struct EpiMlaIn {
    static constexpr bool PERM = true;
    bf16_t* O; float* rsp; float* krope; const float* rsh; LAS const float* tab; int pm_base;
    DI void operator()(const Acc& acc, const Unit& u, int wr, int wc, int fr, int fq) const {
        const int row0 = u.pm * BM + wr * 64 + fr;
        float sc[2][4];
#pragma unroll
        for (int ai = 0; ai < 2; ++ai)
#pragma unroll
            for (int m = 0; m < 4; ++m) sc[ai][m] = hrstd_t(rsh, tab, pm_base, u.pm, wr * 64 + fr + ai * HALF + m * 16, fq);
        if (u.pn < 4) {
            const int col0 = u.pn * BM + wc * 32 + 8 * fq;
#pragma unroll
            for (int ai = 0; ai < 2; ++ai)
#pragma unroll
                for (int m = 0; m < 4; ++m) {
                    const int r = row0 + ai * HALF + m * 16;
                    bf16_t* rowp = O + (size_t)r * 1024 + col0; float ss = 0.f;
#pragma unroll
                    for (int bj = 0; bj < 2; ++bj) {
                        const f32x4 v0 = acc[ai][bj][m][0] * sc[ai][m], v1 = acc[ai][bj][m][1] * sc[ai][m];
                        ss += (v0[0] * v0[0] + v0[1] * v0[1]) + (v0[2] * v0[2] + v0[3] * v0[3]) + (v1[0] * v1[0] + v1[1] * v1[1]) + (v1[2] * v1[2] + v1[3] * v1[3]);
                        u32x4 w; w.x = pk2(v0[0], v0[1]); w.y = pk2(v0[2], v0[3]); w.z = pk2(v1[0], v1[1]); w.w = pk2(v1[2], v1[3]);
                        *(u32x4*)(rowp + bj * HALF) = w;
                    }
                    ss += __shfl_xor(ss, 16); ss += __shfl_xor(ss, 32); if (fq == 0) rsp[(size_t)r * 16 + u.pn * 4 + wc] = ss;
                }
        } else if (wc < 2) {
#pragma unroll
            for (int ai = 0; ai < 2; ++ai)
#pragma unroll
                for (int m = 0; m < 4; ++m) {
                    float* rowp = krope + (size_t)(row0 + ai * HALF + m * 16) * 64 + wc * 32 + 8 * fq;
                    *(f32x4*)(rowp) = acc[ai][0][m][0] * sc[ai][m]; *(f32x4*)(rowp + 4) = acc[ai][0][m][1] * sc[ai][m];
                }
        }
    }
};
template <bool BASE_F32, bool OUT_F32> struct EpiResid {
    static constexpr bool PERM = true;
    const float* base; float* out; bf16_t* xb; float* rsh;
    DI void operator()(const Acc& acc, const Unit& u, int wr, int wc, int fr, int fq) const {
        const int row0 = u.pm * BM + wr * 64 + fr, col0 = u.pn * BM + wc * 32 + 8 * fq;
#pragma unroll
        for (int ai = 0; ai < 2; ++ai)
#pragma unroll
            for (int m = 0; m < 4; ++m) {
                const int r = row0 + ai * HALF + m * 16; const size_t off = (size_t)r * DM + col0; float ss = 0.f;
#pragma unroll
                for (int bj = 0; bj < 2; ++bj) {
                    f32x4 v0, v1;
                    if (BASE_F32) { v0 = *(const f32x4*)(base + off + bj * HALF); v1 = *(const f32x4*)(base + off + bj * HALF + 4); }
                    else { const u32x4 b = *(const u32x4*)(xb + off + bj * HALF); v0 = (f32x4){bf_lo(b.x), bf_hi(b.x), bf_lo(b.y), bf_hi(b.y)}; v1 = (f32x4){bf_lo(b.z), bf_hi(b.z), bf_lo(b.w), bf_hi(b.w)}; }
                    v0 = v0 + acc[ai][bj][m][0]; v1 = v1 + acc[ai][bj][m][1];
                    if (OUT_F32) { *(f32x4*)(out + off + bj * HALF) = v0; *(f32x4*)(out + off + bj * HALF + 4) = v1; }
                    else {
                        ss += (v0[0] * v0[0] + v0[1] * v0[1]) + (v0[2] * v0[2] + v0[3] * v0[3]) + (v1[0] * v1[0] + v1[1] * v1[1]) + (v1[2] * v1[2] + v1[3] * v1[3]);
                        u32x4 w; w.x = pk2(v0[0], v0[1]); w.y = pk2(v0[2], v0[3]); w.z = pk2(v1[0], v1[1]); w.w = pk2(v1[2], v1[3]);
                        *(u32x4*)(xb + off + bj * HALF) = w;
                    }
                }
                if (!OUT_F32) { ss += __shfl_xor(ss, 16); ss += __shfl_xor(ss, 32); if (fq == 0) rsh[(size_t)r * 32 + u.pn * 4 + wc] = ss; }
            }
    }
};

DI float dpp_ror1(float v) { return __builtin_bit_cast(float, __builtin_amdgcn_update_dpp(0, __builtin_bit_cast(int, v), 0x121, 0xf, 0xf, false)); }
DI float dpp_ror2(float v) { return __builtin_bit_cast(float, __builtin_amdgcn_update_dpp(0, __builtin_bit_cast(int, v), 0x122, 0xf, 0xf, false)); }
DI unsigned dpp_ror1u(unsigned v) { return (unsigned)__builtin_amdgcn_mov_dpp((int)v, 0x121, 0xf, 0xf, false); }
DI unsigned dpp_ror2u(unsigned v) { return (unsigned)__builtin_amdgcn_mov_dpp((int)v, 0x122, 0xf, 0xf, false); }
DI unsigned dpp_shr1u(unsigned old, unsigned v) { return (unsigned)__builtin_amdgcn_update_dpp((int)old, (int)v, 0x111, 0xf, 0xf, false); }
DI unsigned dpp_shr2u(unsigned old, unsigned v) { return (unsigned)__builtin_amdgcn_update_dpp((int)old, (int)v, 0x112, 0xf, 0xf, false); }
struct EpiUpConv {
    static constexpr bool PERM = true;
    bf16_t* act; const float* rsh; const float* cw; const float* cb; float* halo; LAS float* xl; LAS const float* tab; int pm_base;
    static DI f32x4 conv4(u32x2 cur, u32x2& p1, u32x2& p2, bool f1, bool f2, f32x4 w0, f32x4 w1, f32x4 w2, f32x4 bb) {
        u32x2 s1, s2; s1.x = dpp_shr1u(p1.x, cur.x); s1.y = dpp_shr1u(p1.y, cur.y); s2.x = dpp_shr2u(p2.x, cur.x); s2.y = dpp_shr2u(p2.y, cur.y);
        p1.x = dpp_ror1u(cur.x); p1.y = dpp_ror1u(cur.y); p2.x = dpp_ror2u(cur.x); p2.y = dpp_ror2u(cur.y);
        f32x4 y;
        y[0] = bb[0] + w0[0] * bf_lo(s2.x) + w1[0] * bf_lo(s1.x) + w2[0] * bf_lo(cur.x);
        y[1] = bb[1] + w0[1] * bf_hi(s2.x) + w1[1] * bf_hi(s1.x) + w2[1] * bf_hi(cur.x);
        y[2] = bb[2] + w0[2] * bf_lo(s2.y) + w1[2] * bf_lo(s1.y) + w2[2] * bf_lo(cur.y);
        y[3] = bb[3] + w0[3] * bf_hi(s2.y) + w1[3] * bf_hi(s1.y) + w2[3] * bf_hi(cur.y);
        return y;
    }
    DI void operator()(Acc& acc, const Unit& u, int wr, int wc, int fr, int fq) const {
        asm volatile("" : "+v"(fr), "+v"(fq));
        const int row0 = u.pm * BM + wr * 64 + fr, cl = wc * 32 + 8 * fq;
        f32x4 wg[2][4], wv[2][4];
#pragma unroll
        for (int n = 0; n < 2; ++n) {
            const int cg = u.pn * 128 + cl + 4 * n, cv = DFF + cg;
            const char* gp = (const char*)cw + (unsigned)(cg * 4); const char* vp = (const char*)cw + (unsigned)(cv * 4);
            wg[n][0] = *(const f32x4*)gp; wg[n][1] = *(const f32x4*)(gp + 8 * DFF); wg[n][2] = *(const f32x4*)(gp + 16 * DFF); wg[n][3] = *(const f32x4*)((const char*)cb + (unsigned)(cg * 4));
            wv[n][0] = *(const f32x4*)vp; wv[n][1] = *(const f32x4*)(vp + 8 * DFF); wv[n][2] = *(const f32x4*)(vp + 16 * DFF); wv[n][3] = *(const f32x4*)((const char*)cb + (unsigned)(cv * 4));
        }
        u32x2 pk[2][2][4][2];
        float scv[2][4];
#pragma unroll
        for (int ai = 0; ai < 2; ++ai)
#pragma unroll
            for (int m = 0; m < 4; ++m) scv[ai][m] = hrstd_t(rsh, tab, pm_base, u.pm, wr * 64 + fr + ai * HALF + m * 16, fq);
#pragma unroll
        for (int ai = 0; ai < 2; ++ai)
#pragma unroll
            for (int m = 0; m < 4; ++m) { const float sc = scv[ai][m];
#pragma unroll
                for (int bj = 0; bj < 2; ++bj) {
                    const f32x4 v0 = acc[ai][bj][m][0] * sc, v1 = acc[ai][bj][m][1] * sc;
                    if (m == 3 && fr >= 14) { LAS float* d = xl + ((((ai * 2 + wr) * 2 + bj) * 2 + (fr - 14)) * 128) + cl; *(LAS f32x4*)d = v0; *(LAS f32x4*)(d + 4) = v1; }
                    if (ai == 0 && m == 0 && wr == 0 && fr < 2) { float* d = (float*)((char*)halo + (unsigned)((((u.pm * 2 + bj) * 4 + fr) * DFF + u.pn * 128 + cl) * 4)); *(f32x4*)d = v0; *(f32x4*)(d + 4) = v1; }
                    if (ai == 1 && m == 3 && wr == 1 && fr >= 14) { float* d = (float*)((char*)halo + (unsigned)((((u.pm * 2 + bj) * 4 + 2 + (fr - 14)) * DFF + u.pn * 128 + cl) * 4)); *(f32x4*)d = v0; *(f32x4*)(d + 4) = v1; }
                    pk[ai][bj][m][0].x = pk2(v0[0], v0[1]); pk[ai][bj][m][0].y = pk2(v0[2], v0[3]); pk[ai][bj][m][1].x = pk2(v1[0], v1[1]); pk[ai][bj][m][1].y = pk2(v1[2], v1[3]);
                }
                __builtin_amdgcn_sched_barrier(0); }
        asm volatile("s_waitcnt lgkmcnt(0)" ::: "memory"); __builtin_amdgcn_s_barrier(); asm volatile("" ::: "memory");
        const bool f1 = fr >= 1, f2 = fr >= 2;
#pragma unroll
        for (int n = 0; n < 2; ++n) {
            const int cg = u.pn * 128 + cl + 4 * n;
            const f32x4 g0 = wg[n][0], g1 = wg[n][1], g2 = wg[n][2], gb = wg[n][3], v0 = wv[n][0], v1 = wv[n][1], v2 = wv[n][2], vbb = wv[n][3];
#pragma unroll
            for (int ai = 0; ai < 2; ++ai) {
                const int sg = wr == 1 ? ai * 2 : 1;
                f32x4 bg_ = *(const LAS f32x4*)(xl + (((sg * 2 + 0) * 2 + (fr & 1)) * 128) + cl + 4 * n), bv_ = *(const LAS f32x4*)(xl + (((sg * 2 + 1) * 2 + (fr & 1)) * 128) + cl + 4 * n);
                if ((ai | wr) == 0) { bg_ = (f32x4){0.f, 0.f, 0.f, 0.f}; bv_ = bg_; }
                u32x2 tg, tv; tg.x = pk2(bg_[0], bg_[1]); tg.y = pk2(bg_[2], bg_[3]); tv.x = pk2(bv_[0], bv_[1]); tv.y = pk2(bv_[2], bv_[3]);
                u32x2 pg1, pg2, pv1, pv2; pg1.x = dpp_ror1u(tg.x); pg1.y = dpp_ror1u(tg.y); pg2.x = dpp_ror2u(tg.x); pg2.y = dpp_ror2u(tg.y);
                pv1.x = dpp_ror1u(tv.x); pv1.y = dpp_ror1u(tv.y); pv2.x = dpp_ror2u(tv.x); pv2.y = dpp_ror2u(tv.y);
#pragma unroll
                for (int m = 0; m < 4; ++m) {
                    const f32x4 yv = conv4(pk[ai][1][m][n], pv1, pv2, f1, f2, v0, v1, v2, vbb);
                    const f32x4 yg = conv4(pk[ai][0][m][n], pg1, pg2, f1, f2, g0, g1, g2, gb);
                    u32x2 w; w.x = pk2(silu(yg[0]) * yv[0], silu(yg[1]) * yv[1]); w.y = pk2(silu(yg[2]) * yv[2], silu(yg[3]) * yv[3]);
                    *(u32x2*)((char*)act + (unsigned)(((row0 + ai * HALF + m * 16) * DFF + cg) * 2)) = w;
                    __builtin_amdgcn_sched_barrier(0);
                }
            }
        }
    }
};

template <class Epi, class Sched, bool ALIGN_EPI = true, bool SP2 = true>
DI void gemm_phase(LAS unsigned char* lds, const Gemm g, const Sched& S, const Epi& E, int wave_s) {
    const int tid = opaque_tid(wave_s), wid = __builtin_amdgcn_readfirstlane(tid >> 6), lane = tid & 63, wr = wid >> 2, wc = wid & 3, fr = lane & 15, fq = lane >> 4;
    const int K = g.K, nt = K / BK;
    unsigned voffA[2], voffB[2];
#pragma unroll
    for (int i = 0; i < 2; ++i) { int R, C; stage_rc(tid * 16 + i * 8192, R, C); const int Rb = Epi::PERM ? ((R & ~31) + perm32(R & 31)) : R;
        voffA[i] = (unsigned)(R * g.lda + C) * 2u; voffB[i] = (unsigned)(Rb * g.ldb + C) * 2u; }
    const size_t kstep = (size_t)(BK * 2);
    const size_t hstepA = (size_t)HALF * g.lda * 2, hstepB = (size_t)HALF * g.ldb * 2;
    const size_t tstepA = 2 * hstepA, tstepB = 2 * hstepB;
    const unsigned ldsw = (unsigned)wid * 1024u;
    const int aoff = lds_byte(wr * 64 + fr, fq * 8), boff = lds_byte(wc * 32 + fr, fq * 8);
#define PG8_SA(b, h) (((b) * 2 + (h)) * HTB)
#define PG8_SB(b, h) ((4 + (b) * 2 + (h)) * HTB)
#define PG8_STAGE(bufoff, gbase, voff) do { _Pragma("unroll") for (int _i = 0; _i < 2; ++_i) \
        __builtin_amdgcn_global_load_lds((const unsigned*)((const char*)(gbase) + (voff)[_i]), (LAS unsigned*)(lds + (bufoff) + ldsw + _i * 8192), 16, 0, 0); } while (0)
#define PG8_LDA(dst, b, h) do { _Pragma("unroll") for (int m = 0; m < 4; ++m) _Pragma("unroll") for (int k = 0; k < 2; ++k) dst[m][k] = *(const LAS bf16x8*)(lds + PG8_SA(b, h) + aoff + m * 2048 + k * 1024); } while (0)
#define PG8_LDB(dst, b, h) do { _Pragma("unroll") for (int n = 0; n < 2; ++n) _Pragma("unroll") for (int k = 0; k < 2; ++k) dst[n][k] = *(const LAS bf16x8*)(lds + PG8_SB(b, h) + boff + n * 2048 + k * 1024); } while (0)
#define PG8_MMA(ai, bj, At, Bt) do { __builtin_amdgcn_s_setprio(1); _Pragma("unroll") for (int m = 0; m < 4; ++m) _Pragma("unroll") for (int n = 0; n < 2; ++n) _Pragma("unroll") for (int k = 0; k < 2; ++k) \
        acc[ai][bj][m][n] = __builtin_amdgcn_mfma_f32_16x16x32_bf16(Bt[n][k], At[m][k], acc[ai][bj][m][n], 0, 0, 0); __builtin_amdgcn_s_setprio(0); } while (0)
#define PG8_WAIT_V(n) asm volatile("s_waitcnt vmcnt(" #n ")" ::: "memory")
#define PG8_WAIT_L(n) asm volatile("s_waitcnt lgkmcnt(" #n ")" ::: "memory")
#define PG8_BAR __builtin_amdgcn_s_barrier()
#define PG8_SCHED __builtin_amdgcn_sched_barrier(0)
    Unit cur, nxt; int ui = 0;
    if (!S.next(0, cur)) return;
    f32x4 acc[2][2][4][2];
#pragma unroll
    for (int a = 0; a < 2; ++a)
#pragma unroll
        for (int b = 0; b < 2; ++b)
#pragma unroll
            for (int m = 0; m < 4; ++m)
#pragma unroll
                for (int n = 0; n < 2; ++n) acc[a][b][m][n] = (f32x4){0.f, 0.f, 0.f, 0.f};
    bf16x8 At[4][2], B0[2][2], B1[2][2];
    const char* cA = (const char*)g.A + (size_t)cur.pm * tstepA; const char* cB = (const char*)g.Bt + (size_t)cur.pn * tstepB;
    {
        PG8_STAGE(PG8_SB(0, 0), cB, voffB); PG8_STAGE(PG8_SB(0, 1), cB + hstepB, voffB); PG8_STAGE(PG8_SA(0, 0), cA, voffA); PG8_STAGE(PG8_SA(0, 1), cA + hstepA, voffA);
        if (wr == 1) PG8_BAR;
        PG8_WAIT_V(2); PG8_BAR;
        PG8_STAGE(PG8_SB(1, 0), cB + kstep, voffB); PG8_STAGE(PG8_SA(1, 0), cA + kstep, voffA); PG8_STAGE(PG8_SB(1, 1), cB + hstepB + kstep, voffB);
        PG8_WAIT_V(6); PG8_BAR;
    }
    for (;;) {
        const bool has_next = S.next(ui + 1, nxt);
        const char* nA = has_next ? (const char*)g.A + (size_t)nxt.pm * tstepA : cA; const char* nB = has_next ? (const char*)g.Bt + (size_t)nxt.pn * tstepB : cB;
        for (int t = 0; t < nt; t += 2) {
            const bool last = (t == nt - 2);
            const char* a1 = cA + (size_t)(t + 1) * kstep;
            const char* a2 = last ? nA : cA + (size_t)(t + 2) * kstep; const char* b2 = last ? nB : cB + (size_t)(t + 2) * kstep;
            const char* a3 = a2 + kstep; const char* b3 = b2 + kstep;
            PG8_LDB(B0, 0, 0); PG8_LDB(B1, 0, 1); PG8_SCHED; PG8_LDA(At, 0, 0); PG8_STAGE(PG8_SA(1, 1), a1 + hstepA, voffA);
            PG8_WAIT_V(8); PG8_WAIT_L(0); PG8_BAR; PG8_MMA(0, 0, At, B0); PG8_MMA(0, 1, At, B1); PG8_BAR; PG8_SCHED;
            PG8_LDA(At, 0, 1); PG8_STAGE(PG8_SB(0, 0), b2, voffB); PG8_STAGE(PG8_SB(0, 1), b2 + hstepB, voffB); PG8_STAGE(PG8_SA(0, 0), a2, voffA);
            PG8_WAIT_V(8); PG8_WAIT_L(0); PG8_BAR; PG8_MMA(1, 0, At, B0); PG8_MMA(1, 1, At, B1); PG8_BAR; PG8_SCHED;
            PG8_LDB(B0, 1, 0); PG8_LDB(B1, 1, 1); PG8_SCHED; PG8_LDA(At, 1, 0); PG8_STAGE(PG8_SA(0, 1), a2 + hstepA, voffA);
            PG8_WAIT_V(8); PG8_WAIT_L(0); PG8_BAR; PG8_MMA(0, 0, At, B0); PG8_MMA(0, 1, At, B1); PG8_BAR; PG8_SCHED;
            PG8_LDA(At, 1, 1); PG8_STAGE(PG8_SB(1, 0), b3, voffB); PG8_STAGE(PG8_SB(1, 1), b3 + hstepB, voffB); PG8_STAGE(PG8_SA(1, 0), a3, voffA);
            PG8_WAIT_V(8); PG8_WAIT_L(0); PG8_BAR; PG8_MMA(1, 0, At, B0); PG8_MMA(1, 1, At, B1); PG8_BAR; PG8_SCHED;
        }
        if constexpr (ALIGN_EPI) { if (wr == 0) PG8_BAR; }
        E(acc, cur, wr, wc, fr, fq);
        if (!has_next) break;
#pragma unroll
        for (int a = 0; a < 2; ++a)
#pragma unroll
            for (int b = 0; b < 2; ++b)
#pragma unroll
                for (int m = 0; m < 4; ++m)
#pragma unroll
                    for (int n = 0; n < 2; ++n) acc[a][b][m][n] = (f32x4){0.f, 0.f, 0.f, 0.f};
        cur = nxt; cA = nA; cB = nB; ++ui;
        if constexpr (ALIGN_EPI) { if (wr == 1) PG8_BAR; }
    }
    PG8_WAIT_V(0);
    if constexpr (!ALIGN_EPI) { if (wr == 0) PG8_BAR; }
    PG8_BAR;
#undef PG8_SA
#undef PG8_SB
#undef PG8_STAGE
#undef PG8_LDA
#undef PG8_LDB
#undef PG8_MMA
#undef PG8_WAIT_V
#undef PG8_WAIT_L
#undef PG8_BAR
#undef PG8_SCHED
}
}

constexpr size_t MiB = 1u << 20;
constexpr size_t WS_RSH = 390 * MiB, WS_RSP = 12 * MiB, WS_RSSGU = 13 * MiB;
constexpr size_t WS_FLOG = 1 * MiB, WS_CUM = 2 * MiB, WS_KROPE = 4 * MiB, WS_RCS = 8 * MiB, WS_RSN = 10 * MiB;
constexpr size_t WS_W = 16 * MiB;
constexpr size_t W_FOX_IN = WS_W, W_FOX_OUT = W_FOX_IN + 25 * MiB, W_MLA_IN = W_FOX_OUT + 8 * MiB, W_MLA_QB = W_MLA_IN + 5 * MiB, W_MLA_KVB = W_MLA_QB + 3 * MiB,
                 W_MLA_OUT = W_MLA_KVB + 4 * MiB, W_SB_IN = W_MLA_OUT + 8 * MiB, W_SB_OUT = W_SB_IN + 24 * MiB, W_SGU_IN = W_SB_OUT + 8 * MiB, W_SGU_OUT = W_SGU_IN + 16 * MiB,
                 W_UP = W_SGU_OUT + 8 * MiB, W_DOWN = W_UP + 4 * 44 * MiB, W_END = W_DOWN + 4 * 22 * MiB;
constexpr size_t WS_XB = 400 * MiB, WS_BIG = 464 * MiB, WS_ACT = 816 * MiB, WS_HALO = 992 * MiB, WS_END = 1004 * MiB;
static_assert(W_END <= WS_XB, "weights fit");

DI void convert_matrix(const float* __restrict__ W, const float* __restrict__ gain, bf16_t* __restrict__ WT, int K, int N, int Npad, LAS float* scrf, int gw, int NGW, int lane, bool perm_up = false) {
    LAS unsigned* scr = (LAS unsigned*)scrf;
    const int nblk = Npad / 64, nitems = (K / 64) * nblk;
    const int c = lane & 15, g = lane >> 4;
    for (int it = gw; it < nitems; it += NGW) {
        const int kb = it / nblk, nb = it % nblk, k0 = 64 * kb, n0 = 64 * nb;
        const int n = n0 + 4 * c; const bool ok = n < N;
        const int nd0 = !perm_up ? n0 : (n0 < DFF ? (n0 >> 7) * 256 + (n0 & 127) : ((n0 - DFF) >> 7) * 256 + 128 + ((n0 - DFF) & 127));
        f32x4 v[16];
        const float* wp = W + (size_t)(k0 + 2 * g) * N + n;
#pragma unroll
        for (int j = 0; j < 8; ++j)
#pragma unroll
            for (int e = 0; e < 2; ++e) v[2 * j + e] = ok ? __builtin_nontemporal_load((const f32x4*)(wp + (size_t)(8 * j + e) * N)) : (f32x4){0.f, 0.f, 0.f, 0.f};
        if (gain) {
#pragma unroll
            for (int j = 0; j < 8; ++j) { const f32x2 gg = *(const f32x2*)(gain + k0 + 8 * j + 2 * g); v[2 * j] = v[2 * j] * gg.x; v[2 * j + 1] = v[2 * j + 1] * gg.y; }
        }
#pragma unroll
        for (int j = 0; j < 8; ++j)
#pragma unroll
            for (int q = 0; q < 4; ++q) scr[(4 * c + q) * 33 + 4 * j + g] = pk2(v[2 * j][q], v[2 * j + 1][q]);
        LDS_WAIT();
#pragma unroll
        for (int i = 0; i < 8; ++i) {
            const int nl = (lane >> 3) + 8 * i, q = lane & 7; const LAS unsigned* sp = scr + nl * 33 + 4 * q;
            u32x4 o; o.x = sp[0]; o.y = sp[1]; o.z = sp[2]; o.w = sp[3];
            *(u32x4*)(WT + (size_t)(nd0 + nl) * K + k0 + 8 * q) = o;
        }
        LDS_WAIT();
    }
}

DI void norm_phase(const float* __restrict__ h, bf16_t* __restrict__ xb, float* __restrict__ rsh, int vcu, int G, int wave_s) {
    const int tid = opaque_tid(wave_s), lane = tid & 63, gw = vcu * 8 + (tid >> 6), NGW = G * 8;
    for (int r = gw; r < M_TOK; r += NGW) {
        const f32x4* xr = (const f32x4*)(h + (size_t)r * DM) + lane;
        f32x4 v[8]; float s = 0.f;
#pragma unroll
        for (int j = 0; j < 8; ++j) { v[j] = xr[64 * j]; s += (v[j].x * v[j].x + v[j].y * v[j].y) + (v[j].z * v[j].z + v[j].w * v[j].w); }
        s = wave_sum(s);
        if (lane < 32) rsh[(size_t)r * 32 + lane] = lane == 0 ? s : 0.f;
        u32x2* o = (u32x2*)(xb + (size_t)r * DM) + lane;
#pragma unroll
        for (int j = 0; j < 8; ++j) { u32x2 w; w.x = pk2(v[j].x, v[j].y); w.y = pk2(v[j].z, v[j].w); o[64 * j] = w; }
    }
}

DI void unpack8(const u32x4 w, float* f) { f[0] = bf_lo(w.x); f[1] = bf_hi(w.x); f[2] = bf_lo(w.y); f[3] = bf_hi(w.y); f[4] = bf_lo(w.z); f[5] = bf_hi(w.z); f[6] = bf_lo(w.w); f[7] = bf_hi(w.w); }
template <int MODE>
DI void kvprep_phase(LAS unsigned char* lds, const bf16_t* __restrict__ src, bf16_t* __restrict__ Kn, bf16_t* __restrict__ Vt, const float* __restrict__ kgain,
                     const float* __restrict__ flog, const float* __restrict__ bfp, float* __restrict__ cum, const float* __restrict__ krope, const float* __restrict__ rcs, const float* __restrict__ rsn,
                     int vcu, int G, int wave_s) {
    constexpr int DQK = MODE == 1 ? 192 : 128, LDS_ = MODE == 1 ? 4096 : 6144;
    const int tid = opaque_tid(wave_s), lane = tid & 63, wid = tid >> 6;
    if (MODE == 0) {
        const int gw = vcu * 8 + wid, NGW = G * 8;
        for (int q = gw; q < 128; q += NGW) {
            const int b = q >> 4, h = q & 15; const float bh_ = bfp[h];
            const float* fl = flog + (size_t)(b * SEQ + 32 * lane) * 16 + h;
            float lf[32]; float tot = 0.f;
#pragma unroll
            for (int j = 0; j < 32; ++j) { const float x = fl[j * 16] + bh_; lf[j] = -(fmaxf(-x, 0.f) + 0.6931471805599453f * fast_log2(1.f + fast_exp2(-LOG2E * fabsf(x)))); tot += lf[j]; }
            float incl = tot;
#pragma unroll
            for (int o = 1; o < 64; o <<= 1) { const float y = __shfl_up(incl, o); if (lane >= o) incl += y; }
            float run = incl - tot;
            float* co = cum + (size_t)q * SEQ + 32 * lane;
#pragma unroll
            for (int j = 0; j < 32; j += 4) { f32x4 o4; run += lf[j]; o4[0] = run; run += lf[j + 1]; o4[1] = run; run += lf[j + 2]; o4[2] = run; run += lf[j + 3]; o4[3] = run; *(f32x4*)(co + j) = o4; }
        }
    }
    if (MODE == 1) {
        constexpr int NIT = M_TOK * 16 * 4;
        const int gt = vcu * 512 + tid, GT = G * 512;
        for (int i = gt; i < NIT; i += GT) {
            const int cc = i & 3, h = (i >> 2) & 15, row = i >> 6;
            const float* kr = krope + (size_t)row * 64 + 8 * cc;
            const f32x4 a0 = *(const f32x4*)kr, a1 = *(const f32x4*)(kr + 4), b0 = *(const f32x4*)(kr + 32), b1 = *(const f32x4*)(kr + 36);
            float x1[8] = {a0[0], a0[1], a0[2], a0[3], a1[0], a1[1], a1[2], a1[3]}, x2[8] = {b0[0], b0[1], b0[2], b0[3], b1[0], b1[1], b1[2], b1[3]};
            float s2 = 0.f;
#pragma unroll
            for (int j = 0; j < 8; ++j) s2 += x1[j] * x1[j] + x2[j] * x2[j];
            s2 += __shfl_xor(s2, 1); s2 += __shfl_xor(s2, 2);
            const float rs = __builtin_amdgcn_rsqf(s2 * (1.f / 64.f) + EPS);
            float r1[8], r2[8];
            const f32x4 c0 = *(const f32x4*)(rcs + (size_t)row * 32 + 8 * cc), c1 = *(const f32x4*)(rcs + (size_t)row * 32 + 8 * cc + 4), n0 = *(const f32x4*)(rsn + (size_t)row * 32 + 8 * cc), n1 = *(const f32x4*)(rsn + (size_t)row * 32 + 8 * cc + 4);
#pragma unroll
            for (int j = 0; j < 8; ++j) {
                const int ii = 8 * cc + j;
                const float cs = j < 4 ? c0[j & 3] : c1[j & 3], sn = j < 4 ? n0[j & 3] : n1[j & 3];
                const float y1 = x1[j] * rs * kgain[128 + ii], y2 = x2[j] * rs * kgain[160 + ii];
                r1[j] = y1 * cs - y2 * sn; r2[j] = y1 * sn + y2 * cs;
            }
            const int b = row >> 11, sq = row & (SEQ - 1);
            bf16_t* ro = Kn + ((size_t)(b * 16 + h) * SEQ + sq) * DQK + 128 + 8 * cc;
            u32x4 w1, w2; w1.x = pk2(r1[0], r1[1]); w1.y = pk2(r1[2], r1[3]); w1.z = pk2(r1[4], r1[5]); w1.w = pk2(r1[6], r1[7]);
            w2.x = pk2(r2[0], r2[1]); w2.y = pk2(r2[2], r2[3]); w2.z = pk2(r2[4], r2[5]); w2.w = pk2(r2[6], r2[7]);
            *(u32x4*)ro = w1; *(u32x4*)(ro + 32) = w2;
        }
    }
}

#define MFMA32(a, b, c) __builtin_amdgcn_mfma_f32_32x32x16_bf16((a), (b), (c), 0, 0, 0)
template <int MODE>
DI void attn_phase(LAS unsigned char* lds, const bf16_t* __restrict__ Q, int ldq, int qhs, const bf16_t* __restrict__ Kn, const bf16_t* __restrict__ Vsrc, int ldv, int vhs,
                   const float* __restrict__ cum, const float* qgain, const float* __restrict__ rcs, const float* __restrict__ rsn, bf16_t* __restrict__ O, int vcu, int G, int wave_s) {
    constexpr int DQK = MODE == 1 ? 192 : 128, NST = DQK / 16, KP = DQK * 2 + 16, KBUF = 64 * KP, VP = 272, VBUF = 64 * VP, KCH = DQK / 8, KPT = 64 * KCH / 512;
    constexpr int OFF_V = 2 * KBUF, OFF_C = OFF_V + 3 * VBUF;
    const int tid = opaque_tid(wave_s), lane = tid & 63, w = __builtin_amdgcn_readfirstlane(tid >> 6), r32 = lane & 31, hi = lane >> 5;
    const float CS = (MODE == 1 ? 0.07216878364870322f : 0.08838834764831845f) * LOG2E;
    float fox_thr = 0.f;
    if constexpr (MODE == 0) {
        float gq = fmaxf(fabsf(qgain[lane]), fabsf(qgain[lane + 64])), gk = fmaxf(fabsf(rcs[lane]), fabsf(rcs[lane + 64]));
#pragma unroll
        for (int o = 1; o < 64; o <<= 1) { gq = fmaxf(gq, __shfl_xor(gq, o)); gk = fmaxf(gk, __shfl_xor(gk, o)); }
        fox_thr = 2.02f * (128.f * CS * gq * gk) + 160.f;
    }
    const int pim = (r32 & 0x13) | ((r32 & 4) << 1) | ((r32 & 8) >> 1);
    const unsigned kfo = pim * KP + hi * 16;
    const unsigned vfo = (unsigned)((8 * hi + ((lane & 15) >> 2)) * VP + ((lane >> 4) & 1) * 32 + (lane & 3) * 8);
    for (int g = vcu; g < 512; g += G) {
        const int bh = g >> 2, sub = g & 3, b = bh >> 4, h = bh & 15;
        const bf16_t* Kbh = Kn + (size_t)bh * SEQ * DQK; const bf16_t* Vbh = Vsrc + (size_t)b * SEQ * ldv + h * vhs; const float* cbh = cum + (size_t)bh * SEQ;
        for (int k4 = 0; k4 < 2; ++k4) {
            const int qb = (k4 == 0) ? 7 - sub : sub;
            const int q0 = qb * 256, NT = 4 * (qb + 1);
            int toff = 0;
            if constexpr (MODE == 0) {
                const float cq0 = cbh[q0];
                const bool far_ = lane < NT && (cbh[64 * (lane < NT ? lane : 0) + 63] - cq0) * LOG2E >= fox_thr;
                toff = (int)__popcll(__ballot(far_)); if (toff > NT - 1) toff = NT - 1;
                toff = __builtin_amdgcn_readfirstlane(toff);
            }
            const int NTe = NT - toff;
            const int qmin = q0 + 32 * w, qmax = qmin + 31, qg = qmin + r32;
            u32x4 kreg[KPT], vreg[2]; float creg = 0.f;
            int tidu = tid; asm volatile("" : "+v"(tidu));
            const unsigned kgo = (unsigned)(tidu * KPT * 16), vgo = (unsigned)(((tidu >> 3) * ldv + (tidu & 7) * 16) * 2);
            const unsigned klo = (unsigned)(((tidu * KPT) / KCH) * KP + ((tidu * KPT) % KCH) * 16), vlo = (unsigned)((tidu >> 3) * VP + (tidu & 7) * 32);
#define ATT_LOAD(t_) do { const int s0_ = (t_) * 64; const char* kg_ = (const char*)(Kbh + (size_t)s0_ * DQK) + kgo; const char* vg_ = (const char*)(Vbh + (size_t)s0_ * ldv) + vgo; \
        _Pragma("unroll") for (int i_ = 0; i_ < KPT; ++i_) kreg[i_] = *(const u32x4*)(kg_ + i_ * 16); \
        _Pragma("unroll") for (int i_ = 0; i_ < 2; ++i_) vreg[i_] = *(const u32x4*)(vg_ + i_ * 16); \
        if (MODE == 0) { if (tid < 64) creg = cbh[s0_ + tid] * LOG2E; } } while (0)
#define ATT_STORE(buf_, vbuf_) do { LAS unsigned char* kb_ = lds + (buf_) * KBUF + klo; \
        _Pragma("unroll") for (int i_ = 0; i_ < KPT; ++i_) *(LAS u32x4*)(kb_ + i_ * 16) = kreg[i_]; \
        LAS unsigned char* vb_ = lds + OFF_V + (vbuf_) * VBUF + vlo; \
        _Pragma("unroll") for (int i_ = 0; i_ < 2; ++i_) *(LAS u32x4*)(vb_ + i_ * 16) = vreg[i_]; \
        if (MODE == 0) { if (tid < 64) ((LAS float*)(lds + OFF_C))[(buf_) * 64 + tid] = creg; } } while (0)
            ATT_LOAD((MODE == 2) ? NT - 1 : toff);
            bf16x8 qf[NST];
            {
                const float* qgl = qgain; asm volatile("" : "+s"(qgl));
                int r32q = r32, hiq = hi; asm volatile("" : "+v"(r32q), "+v"(hiq));
                const bf16_t* qrow = (Q + (size_t)(b * SEQ + qmin) * ldq + h * qhs) + (unsigned)(r32q * ldq + 8 * hiq);
                u32x4 raw[NST];
#pragma unroll
                for (int st = 0; st < NST; ++st) raw[st] = *(const u32x4*)(qrow + 16 * st);
                float ssn = 0.f;
#pragma unroll
                for (int st = 0; st < 8; ++st) { float f[8]; unpack8(raw[st], f);
#pragma unroll
                    for (int j = 0; j < 8; ++j) ssn += f[j] * f[j]; }
                ssn += __shfl_xor(ssn, 32);
                const float rn = CS / sqrtf(ssn * (1.f / 128.f) + EPS);
#pragma unroll
                for (int st = 0; st < 8; ++st) { float f[8]; unpack8(raw[st], f);
                    const f32x4 g0 = *(const f32x4*)(qgl + 16 * st + 8 * hi), g1 = *(const f32x4*)(qgl + 16 * st + 8 * hi + 4);
                    u32x4 o; o.x = pk2(f[0] * rn * g0[0], f[1] * rn * g0[1]); o.y = pk2(f[2] * rn * g0[2], f[3] * rn * g0[3]);
                    o.z = pk2(f[4] * rn * g1[0], f[5] * rn * g1[1]); o.w = pk2(f[6] * rn * g1[2], f[7] * rn * g1[3]);
                    qf[st] = __builtin_bit_cast(bf16x8, o); }
                if constexpr (MODE == 1) {
                    float ssr = 0.f;
#pragma unroll
                    for (int st = 8; st < 12; ++st) { float f[8]; unpack8(raw[st], f);
#pragma unroll
                        for (int j = 0; j < 8; ++j) ssr += f[j] * f[j]; }
                    ssr += __shfl_xor(ssr, 32);
                    const float rr = 1.0f / sqrtf(ssr * (1.f / 64.f) + EPS);
                    const float* tc = (rcs + (size_t)(b * SEQ + qmin) * 32) + (unsigned)(r32q * 32 + 8 * hiq); const float* tn = (rsn + (size_t)(b * SEQ + qmin) * 32) + (unsigned)(r32q * 32 + 8 * hiq);
#pragma unroll
                    for (int a = 0; a < 2; ++a) {
                        float f1[8], f2[8], o1[8], o2[8]; unpack8(raw[8 + a], f1); unpack8(raw[10 + a], f2);
                        const f32x4 c0 = *(const f32x4*)(tc + 16 * a), c1 = *(const f32x4*)(tc + 16 * a + 4), n0 = *(const f32x4*)(tn + 16 * a), n1 = *(const f32x4*)(tn + 16 * a + 4);
#pragma unroll
                        for (int j = 0; j < 8; ++j) {
                            const int i = 16 * a + 8 * hi + j;
                            const float cs = j < 4 ? c0[j & 3] : c1[j & 3], sn = j < 4 ? n0[j & 3] : n1[j & 3];
                            const float y1 = f1[j] * rr * qgl[128 + i], y2 = f2[j] * rr * qgl[160 + i];
                            o1[j] = (y1 * cs - y2 * sn) * CS; o2[j] = (y1 * sn + y2 * cs) * CS;
                        }
                        u32x4 w1, w2; w1.x = pk2(o1[0], o1[1]); w1.y = pk2(o1[2], o1[3]); w1.z = pk2(o1[4], o1[5]); w1.w = pk2(o1[6], o1[7]);
                        w2.x = pk2(o2[0], o2[1]); w2.y = pk2(o2[2], o2[3]); w2.z = pk2(o2[4], o2[5]); w2.w = pk2(o2[6], o2[7]);
                        qf[8 + a] = __builtin_bit_cast(bf16x8, w1); qf[10 + a] = __builtin_bit_cast(bf16x8, w2);
                    }
                }
            }
            float m_run = -INFINITY, l_run = 0.f, carry = 1.f;
            f32x16 o[4];
#pragma unroll
            for (int d = 0; d < 4; ++d)
#pragma unroll
                for (int i = 0; i < 16; ++i) o[d][i] = 0.f;
#define ATT_PV(vbi_) do { LAS const unsigned char* vb = lds + OFF_V + (vbi_) * VBUF + vfo; \
        _Pragma("unroll") for (int d = 0; d < 4; ++d) { \
            _Pragma("unroll") for (int s_ = 0; s_ < 4; ++s_) { \
                const s16x4 vlo_ = __builtin_bit_cast(s16x4, __builtin_amdgcn_ds_read_tr16_b64_v4i16((LAS s16x4*)(vb + s_ * 16 * VP + d * 64))); \
                const s16x4 vhi_ = __builtin_bit_cast(s16x4, __builtin_amdgcn_ds_read_tr16_b64_v4i16((LAS s16x4*)(vb + (s_ * 16 + 4) * VP + d * 64))); \
                const bf16x8 vf = __builtin_shufflevector(vlo_, vhi_, 0, 1, 2, 3, 4, 5, 6, 7); \
                o[d] = MFMA32(vf, pf[s_], o[d]); } \
            __builtin_amdgcn_sched_barrier(0); } } while (0)
            const bool late = w >= 4; bool havep = false; int vprev = 0;
            bf16x8 pf[4];
#pragma unroll
            for (int i = 0; i < 4; ++i) pf[i] = (bf16x8){0, 0, 0, 0, 0, 0, 0, 0};
            ATT_STORE(0, 0); __syncthreads();
            int vcur = 0;
            for (int it = 0; it < NTe; ++it) {
                const int t = (MODE == 2) ? NT - 1 - it : it + toff, tn = (MODE == 2) ? t - 1 : t + 1; const bool more = it + 1 < NTe; const int buf = it & 1;
                if (more) ATT_LOAD(tn);
                if (havep) { ATT_PV(vprev); havep = false; }
                if (64 * t <= qmax) {
                    LAS const unsigned char* kb = lds + buf * KBUF + kfo;
                    f32x16 p0, p1;
#pragma unroll
                    for (int i = 0; i < 16; ++i) { p0[i] = 0.f; p1[i] = 0.f; }
#pragma unroll
                    for (int st = 0; st < NST; ++st) {
                        const bf16x8 k0 = *(LAS const bf16x8*)(kb + st * 32), k1 = *(LAS const bf16x8*)(kb + 32 * KP + st * 32);
                        p0 = MFMA32(k0, qf[st], p0); p1 = MFMA32(k1, qf[st], p1);
                        if ((st & 7) == 7) __builtin_amdgcn_sched_barrier(0);
                    }
                    if constexpr (MODE == 0) {
                        LAS const float* cb = (LAS const float*)(lds + OFF_C) + buf * 64 + 8 * hi;
#pragma unroll
                        for (int a = 0; a < 2; ++a) {
                            const f32x4 c0 = *(LAS const f32x4*)(cb + 16 * a), c1 = *(LAS const f32x4*)(cb + 16 * a + 4), c2 = *(LAS const f32x4*)(cb + 32 + 16 * a), c3 = *(LAS const f32x4*)(cb + 32 + 16 * a + 4);
#pragma unroll
                            for (int j = 0; j < 4; ++j) { p0[8 * a + j] -= c0[j]; p0[8 * a + 4 + j] -= c1[j]; p1[8 * a + j] -= c2[j]; p1[8 * a + 4 + j] -= c3[j]; }
                        }
                    }
                    if (64 * t + 63 >= qmin) {
#pragma unroll
                        for (int i = 0; i < 16; ++i) {
                            const int key = 64 * t + 16 * (i >> 3) + 8 * hi + (i & 7);
                            const bool m0 = (MODE == 2) ? (key >= qg) : (key > qg), m1 = (MODE == 2) ? (key + 32 >= qg) : (key + 32 > qg);
                            if (m0) p0[i] = -INFINITY; if (m1) p1[i] = -INFINITY;
                        }
                    }
                    if constexpr (MODE != 2) {
                        float mx = p0[0];
#pragma unroll
                        for (int i = 1; i < 16; ++i) mx = fmaxf(mx, p0[i]);
#pragma unroll
                        for (int i = 0; i < 16; ++i) mx = fmaxf(mx, p1[i]);
                        mx = fmaxf(mx, __shfl_xor(mx, 32));
                        const float m_new = fmaxf(m_run, mx);
                        const float alpha = fast_exp2(m_run - m_new);
                        m_run = m_new;
                        float rs = 0.f;
#pragma unroll
                        for (int i = 0; i < 16; ++i) { p0[i] = fast_exp2(p0[i] - m_new); p1[i] = fast_exp2(p1[i] - m_new); rs += p0[i] + p1[i]; }
                        l_run = l_run * alpha + rs;
                        if (!__all(alpha == 1.0f)) {
#pragma unroll
                            for (int d = 0; d < 4; ++d)
#pragma unroll
                                for (int i = 0; i < 16; ++i) o[d][i] *= alpha;
                        }
                    } else {
                        f32x16 l0, l1;
#pragma unroll
                        for (int i = 0; i < 16; ++i) {
                            const float e0_ = fast_exp2(fminf(p0[i], 100.f)), e1_ = fast_exp2(fminf(p1[i], 100.f));
                            l0[i] = fast_rcp(1.f + e0_); l1[i] = fast_rcp(1.f + e1_);
                            p0[i] = e0_ * l0[i]; p1[i] = e1_ * l1[i];
                            if ((i & 3) == 3) __builtin_amdgcn_sched_barrier(0);
                        }
                        __builtin_amdgcn_sched_barrier(0);
                        float own0 = 1.f, own1 = 1.f, own2 = 1.f, own3 = 1.f;
#pragma unroll
                        for (int j = 0; j < 8; ++j) { own0 *= l0[j]; own1 *= l0[8 + j]; own2 *= l1[j]; own3 *= l1[8 + j]; }
                        __builtin_amdgcn_sched_barrier(0);
                        const float oth0 = __shfl_xor(own0, 32), oth1 = __shfl_xor(own1, 32), oth2 = __shfl_xor(own2, 32), oth3 = __shfl_xor(own3, 32);
                        const float so2 = own3, so1 = own3 * own2, so0 = so1 * own1;
                        const float st3 = oth3, st2 = st3 * oth2, st1 = st2 * oth1, st0 = st1 * oth0;
                        const float e0 = carry * so0 * (hi ? st1 : st0), e1 = carry * so1 * (hi ? st2 : st1), e2 = carry * so2 * (hi ? st3 : st2), e3 = carry * (hi ? 1.f : st3);
                        {
                            float run = e0;
#pragma unroll
                            for (int jj = 0; jj < 8; ++jj) { const int i = 7 - jj; p0[i] *= run; run *= l0[i]; }
                            __builtin_amdgcn_sched_barrier(0);
                            run = e1;
#pragma unroll
                            for (int jj = 0; jj < 8; ++jj) { const int i = 15 - jj; p0[i] *= run; run *= l0[i]; }
                            __builtin_amdgcn_sched_barrier(0);
                            run = e2;
#pragma unroll
                            for (int jj = 0; jj < 8; ++jj) { const int i = 7 - jj; p1[i] *= run; run *= l1[i]; }
                            __builtin_amdgcn_sched_barrier(0);
                            run = e3;
#pragma unroll
                            for (int jj = 0; jj < 8; ++jj) { const int i = 15 - jj; p1[i] *= run; run *= l1[i]; }
                        }
                        carry *= so0 * own0 * st0;
                    }
                    { u32x4 w_; w_.x = pk2(p0[0], p0[1]); w_.y = pk2(p0[2], p0[3]); w_.z = pk2(p0[4], p0[5]); w_.w = pk2(p0[6], p0[7]); pf[0] = __builtin_bit_cast(bf16x8, w_);
                      w_.x = pk2(p0[8], p0[9]); w_.y = pk2(p0[10], p0[11]); w_.z = pk2(p0[12], p0[13]); w_.w = pk2(p0[14], p0[15]); pf[1] = __builtin_bit_cast(bf16x8, w_);
                      w_.x = pk2(p1[0], p1[1]); w_.y = pk2(p1[2], p1[3]); w_.z = pk2(p1[4], p1[5]); w_.w = pk2(p1[6], p1[7]); pf[2] = __builtin_bit_cast(bf16x8, w_);
                      w_.x = pk2(p1[8], p1[9]); w_.y = pk2(p1[10], p1[11]); w_.z = pk2(p1[12], p1[13]); w_.w = pk2(p1[14], p1[15]); pf[3] = __builtin_bit_cast(bf16x8, w_); }
                    __builtin_amdgcn_sched_barrier(0);
                    if (late) { havep = true; vprev = vcur; } else { ATT_PV(vcur); }
                }
                const int vnext = vcur == 2 ? 0 : vcur + 1;
                if (more) ATT_STORE(buf ^ 1, vnext);
                vcur = vnext;
                if constexpr (MODE == 2) {
                    const bool dead_w = __all(carry < 1e-37f);
                    if (lane == 0) ((LAS unsigned*)(lds + 131072 - 64))[(it & 1) * 8 + w] = dead_w ? 1u : 0u;
                }
                __syncthreads();
                if constexpr (MODE == 2) {
                    const u32x4 f0 = *(LAS const u32x4*)(lds + 131072 - 64 + (it & 1) * 32), f1 = *(LAS const u32x4*)(lds + 131072 - 64 + (it & 1) * 32 + 16);
                    if ((f0.x & f0.y & f0.z & f0.w & f1.x & f1.y & f1.z & f1.w) != 0u) break;
                }
            }
            if (havep) { ATT_PV(vprev); }
#undef ATT_PV
#undef ATT_LOAD
#undef ATT_STORE
            float inv = 1.f;
            if constexpr (MODE != 2) { const float l = l_run + __shfl_xor(l_run, 32); inv = 1.0f / l; }
            int r32o = r32, hio = hi; asm volatile("" : "+v"(r32o), "+v"(hio));
            bf16_t* orow = (O + (size_t)(b * SEQ + qmin) * DM + h * 128) + (unsigned)(r32o * DM + 4 * hio);
#pragma unroll
            for (int d = 0; d < 4; ++d)
#pragma unroll
                for (int g4 = 0; g4 < 4; ++g4) {
                    u32x2 w_; w_.x = pk2(o[d][4 * g4] * inv, o[d][4 * g4 + 1] * inv); w_.y = pk2(o[d][4 * g4 + 2] * inv, o[d][4 * g4 + 3] * inv);
                    *(u32x2*)(orow + 32 * d + 8 * g4) = w_;
                }
            __syncthreads();
        }
    }
}

DI void sgu_phase(LAS unsigned char* lds, const bf16_t* __restrict__ uv, const float* __restrict__ rowss, const float* __restrict__ vgain, const float* __restrict__ ws,
                  const float* __restrict__ bs, bf16_t* __restrict__ Gout, int vcu, int G, int wave_s) {
    constexpr int AP = 272, OFF_VT = 128 * AP, OFF_RS = 2 * 128 * AP;
    const int tid = opaque_tid(wave_s), lane = tid & 63, w = __builtin_amdgcn_readfirstlane(tid >> 6), r32 = lane & 31, hi = lane >> 5;
    for (int su = vcu; su < 256; su += G) {
        const int g = su >> 4, c0 = (su & 15) * 8;
        __syncthreads();
#pragma unroll
        for (int i = 0; i < 8; ++i) {
            const int ci = tid + 512 * i, t = ci >> 5, s4 = (ci & 31) * 4;
            f32x4 v = *(const f32x4*)(ws + (size_t)g * 16384 + t * 128 + s4);
#pragma unroll
            for (int j = 0; j < 4; ++j) if (s4 + j > t) v[j] = 0.f;
            u32x2 o; o.x = pk2(v[0], v[1]); o.y = pk2(v[2], v[3]);
            *(LAS u32x2*)(lds + t * AP + s4 * 2) = o;
        }
        const int rr = tid >> 2, part = tid & 3;
        u32x4 raw[4]; f32x4 pa, pb;
#define SGU_LOAD(ch_) do { const int rb_ = (c0 + (ch_)) * 128; \
        _Pragma("unroll") for (int i = 0; i < 4; ++i) { const int ci = tid + 512 * i; raw[i] = *(const u32x4*)(uv + (size_t)(rb_ + (ci >> 4)) * 4096 + 2048 + g * 128 + (ci & 15) * 8); } \
        pa = *(const f32x4*)(rowss + (size_t)(rb_ + rr) * 32 + part * 8); pb = *(const f32x4*)(rowss + (size_t)(rb_ + rr) * 32 + part * 8 + 4); } while (0)
        SGU_LOAD(0);
        for (int ch = 0; ch < 8; ++ch) {
            const int rbase = (c0 + ch) * 128;
            __syncthreads();
            {
                float ssum = ((pa[0] + pa[1]) + (pa[2] + pa[3])) + ((pb[0] + pb[1]) + (pb[2] + pb[3]));
                ssum += __shfl_xor(ssum, 1); ssum += __shfl_xor(ssum, 2);
                if (part == 0) ((LAS float*)(lds + OFF_RS))[rr] = __builtin_amdgcn_rsqf(ssum * (1.f / 2048.f) + EPS);
            }
            __syncthreads();
#pragma unroll
            for (int i = 0; i < 4; ++i) {
                const int ci = tid + 512 * i, s_ = ci >> 4, cc = (ci & 15) * 8;
                const float rstd = ((LAS const float*)(lds + OFF_RS))[s_];
                float f[8]; unpack8(raw[i], f);
#pragma unroll
                for (int j = 0; j < 8; j += 2) { const unsigned pw = pk2(f[j] * rstd, f[j + 1] * rstd);
                    *(LAS bf16_t*)(lds + OFF_VT + (cc + j) * AP + s_ * 2) = (bf16_t)(pw & 0xffffu); *(LAS bf16_t*)(lds + OFF_VT + (cc + j + 1) * AP + s_ * 2) = (bf16_t)(pw >> 16); }
            }
            if (ch + 1 < 8) SGU_LOAD(ch + 1);
            const int tb = w >> 1, cb0 = (w & 1) * 2, nsteps = 2 * (tb + 1);
            const int t = 32 * tb + r32; const size_t row = (size_t)rbase + t; const float bias = bs[g * 128 + t];
            u32x2 uu[2][4];
#pragma unroll
            for (int cbk = 0; cbk < 2; ++cbk)
#pragma unroll
                for (int g4 = 0; g4 < 4; ++g4) uu[cbk][g4] = *(const u32x2*)(uv + row * 4096 + g * 128 + 32 * (cb0 + cbk) + 8 * g4 + 4 * hi);
            __syncthreads();
            f32x16 a0, a1;
#pragma unroll
            for (int i = 0; i < 16; ++i) { a0[i] = 0.f; a1[i] = 0.f; }
            LAS const unsigned char* ap = lds + (32 * tb + r32) * AP + hi * 16;
            LAS const unsigned char* vp0 = lds + OFF_VT + (32 * cb0 + r32) * AP + hi * 16;
            for (int st = 0; st < nsteps; ++st) {
                const bf16x8 bf_ = *(LAS const bf16x8*)(ap + st * 32);
                const bf16x8 v0 = *(LAS const bf16x8*)(vp0 + st * 32), v1 = *(LAS const bf16x8*)(vp0 + 32 * AP + st * 32);
                a0 = MFMA32(v0, bf_, a0); a1 = MFMA32(v1, bf_, a1);
            }
#pragma unroll
            for (int cbk = 0; cbk < 2; ++cbk)
#pragma unroll
                for (int g4 = 0; g4 < 4; ++g4) {
                    const int c = 32 * (cb0 + cbk) + 8 * g4 + 4 * hi;
                    const f32x4 vg = *(const f32x4*)(vgain + g * 128 + c);
                    const u32x2 uq = uu[cbk][g4];
                    const float u0 = bf_lo(uq.x), u1 = bf_hi(uq.x), u2 = bf_lo(uq.y), u3 = bf_hi(uq.y);
                    const float m0 = (cbk ? a1[4 * g4] : a0[4 * g4]) * vg[0] + bias, m1 = (cbk ? a1[4 * g4 + 1] : a0[4 * g4 + 1]) * vg[1] + bias;
                    const float m2 = (cbk ? a1[4 * g4 + 2] : a0[4 * g4 + 2]) * vg[2] + bias, m3 = (cbk ? a1[4 * g4 + 3] : a0[4 * g4 + 3]) * vg[3] + bias;
                    u32x2 o; o.x = pk2(u0 * m0, u1 * m1); o.y = pk2(u2 * m2, u3 * m3);
                    *(u32x2*)(Gout + row * DM + g * 128 + c) = o;
                }
        }
#undef SGU_LOAD
    }
    __syncthreads();
}

DI void convact_phase(const bf16_t* __restrict__ up, const float* __restrict__ cw, const float* __restrict__ cbias, bf16_t* __restrict__ act, int bx, int G, int wave_s) {
    const int gtid = bx * 512 + opaque_tid(wave_s), GT = G * 512;
    constexpr int FCH = DFF / 8, RS = 16, NITEMS = (M_TOK / RS) * FCH, LDU = 2 * DFF;
    for (int it = gtid; it < NITEMS; it += GT) {
        const int fc = it % FCH, strip = it / FCH, f0 = fc * 8, r0 = strip * RS;
        float wg[3][8], wv[3][8], bg[8], bv[8];
#pragma unroll
        for (int tp = 0; tp < 3; ++tp) {
            const f32x4 a = *(const f32x4*)(cw + tp * LDU + f0), b = *(const f32x4*)(cw + tp * LDU + f0 + 4), c = *(const f32x4*)(cw + tp * LDU + DFF + f0), d = *(const f32x4*)(cw + tp * LDU + DFF + f0 + 4);
#pragma unroll
            for (int j = 0; j < 4; ++j) { wg[tp][j] = a[j]; wg[tp][4 + j] = b[j]; wv[tp][j] = c[j]; wv[tp][4 + j] = d[j]; }
        }
        {
            const f32x4 a = *(const f32x4*)(cbias + f0), b = *(const f32x4*)(cbias + f0 + 4), c = *(const f32x4*)(cbias + DFF + f0), d = *(const f32x4*)(cbias + DFF + f0 + 4);
#pragma unroll
            for (int j = 0; j < 4; ++j) { bg[j] = a[j]; bg[4 + j] = b[j]; bv[j] = c[j]; bv[4 + j] = d[j]; }
        }
        float g2[8], g1[8], v2[8], v1[8];
        if ((r0 & (SEQ - 1)) == 0) {
#pragma unroll
            for (int j = 0; j < 8; ++j) { g2[j] = 0.f; g1[j] = 0.f; v2[j] = 0.f; v1[j] = 0.f; }
        } else {
            const bf16_t* p2 = up + (size_t)(r0 - 2) * LDU + f0; const bf16_t* p1 = p2 + LDU;
            unpack8(*(const u32x4*)p2, g2); unpack8(*(const u32x4*)(p2 + DFF), v2); unpack8(*(const u32x4*)p1, g1); unpack8(*(const u32x4*)(p1 + DFF), v1);
        }
#pragma unroll 4
        for (int rr = 0; rr < RS; ++rr) {
            const bf16_t* p0 = up + (size_t)(r0 + rr) * LDU + f0;
            float gc[8], vc[8]; unpack8(*(const u32x4*)p0, gc); unpack8(*(const u32x4*)(p0 + DFF), vc);
            float o[8];
#pragma unroll
            for (int j = 0; j < 8; ++j) {
                const float yg = bg[j] + wg[0][j] * g2[j] + wg[1][j] * g1[j] + wg[2][j] * gc[j];
                const float yv = bv[j] + wv[0][j] * v2[j] + wv[1][j] * v1[j] + wv[2][j] * vc[j];
                o[j] = silu(yg) * yv;
                g2[j] = g1[j]; g1[j] = gc[j]; v2[j] = v1[j]; v1[j] = vc[j];
            }
            u32x4 w; w.x = pk2(o[0], o[1]); w.y = pk2(o[2], o[3]); w.z = pk2(o[4], o[5]); w.w = pk2(o[6], o[7]);
            *(u32x4*)(act + (size_t)(r0 + rr) * DFF + f0) = w;
        }
    }
}

DI void ffn_fix_phase(const float* __restrict__ halo, const float* __restrict__ cw, const float* __restrict__ cb, bf16_t* __restrict__ act, int bx, int G, int wave_s) {
    const int gtid = bx * 512 + opaque_tid(wave_s), GT = G * 512;
    constexpr int FQ = DFF / 4, NIT = 56 * FQ;
    for (int it = gtid; it < NIT; it += GT) {
        const int f = (it % FQ) * 4, k = it / FQ, pm = (k / 7) * 8 + 1 + (k % 7);
        f32x4 yr[2][2];
#pragma unroll
        for (int bj = 0; bj < 2; ++bj) {
            const float* hp = halo + ((size_t)((pm - 1) * 2 + bj) * 4) * DFF + f; const float* hc = halo + ((size_t)(pm * 2 + bj) * 4) * DFF + f;
            const f32x4 a2 = *(const f32x4*)(hp + 2 * DFF), a1 = *(const f32x4*)(hp + 3 * DFF), c0 = *(const f32x4*)hc, c1 = *(const f32x4*)(hc + DFF);
            const int c = bj * DFF + f;
            const f32x4 w0 = *(const f32x4*)(cw + c), w1 = *(const f32x4*)(cw + 2 * DFF + c), w2 = *(const f32x4*)(cw + 4 * DFF + c), bb = *(const f32x4*)(cb + c);
            yr[bj][0] = bb + w0 * a2 + w1 * a1 + w2 * c0; yr[bj][1] = bb + w0 * a1 + w1 * c0 + w2 * c1;
        }
#pragma unroll
        for (int rr = 0; rr < 2; ++rr) { u32x2 w; w.x = pk2(silu(yr[0][rr][0]) * yr[1][rr][0], silu(yr[0][rr][1]) * yr[1][rr][1]); w.y = pk2(silu(yr[0][rr][2]) * yr[1][rr][2], silu(yr[0][rr][3]) * yr[1][rr][3]);
            *(u32x2*)(act + (size_t)(pm * 256 + rr) * DFF + f) = w; }
    }
}

#define XB_XCNT(j)  (256  + 64 * (j))
#define XB_XSUB(j)  (1280 + 64 * (j))
#define XB_XGEN(j)  (2304 + 64 * (j))
#define XB_TOP      3328
#define XB_TOPGEN   3392
#define XCD_BAR_WORDS 3456
DI unsigned xb_ld(unsigned* p) { return __hip_atomic_load(p, __ATOMIC_RELAXED, __HIP_MEMORY_SCOPE_AGENT); }
DI unsigned xb_add(unsigned* p, unsigned v) { return __hip_atomic_fetch_add(p, v, __ATOMIC_RELAXED, __HIP_MEMORY_SCOPE_AGENT); }
DI unsigned xb_xcc_id() { return (unsigned)__builtin_amdgcn_s_getreg((3 << 11) | 20) & 0xFu; }
#define XB_SPIN(cond) do { unsigned _sp = 0; while (cond) { __builtin_amdgcn_s_sleep(1); if (++_sp > (1u << 24)) break; } } while (0)
DI void xcd_barrier(unsigned* bar, volatile LAS unsigned* st, int tid) {
    asm volatile("s_waitcnt vmcnt(0) lgkmcnt(0)" ::: "memory");
    __syncthreads();
    if (tid == 0) {
        const unsigned x = xb_xcc_id();
        unsigned nloc = st[0], nx = st[1];
        if (nloc == 0u) {
            const unsigned G = gridDim.x; unsigned sp = 0;
            for (;;) {
                unsigned sum = 0u, cnt = 0u, mine = 0u;
#pragma unroll
                for (unsigned j = 0; j < 16; ++j) { const unsigned c = xb_ld(&bar[XB_XCNT(j)]); sum += c; cnt += (c > 0u) ? 1u : 0u; mine = (j == x) ? c : mine; }
                nloc = mine > 0u ? mine : 1u; nx = cnt > 0u ? cnt : 1u;
                if (sum == G) break;
                __builtin_amdgcn_s_sleep(1); if (++sp > (1u << 22)) break;
            }
            st[0] = nloc; st[1] = nx;
        }
        const unsigned old = xb_add(&bar[XB_XSUB(x)], 1u);
        const unsigned gen = old / nloc;
        if (old + 1u == (gen + 1u) * nloc) {
            __builtin_amdgcn_fence(__ATOMIC_RELEASE, "agent");
            asm volatile("s_waitcnt vmcnt(0)" ::: "memory");
            const unsigned og = xb_add(&bar[XB_TOP], 1u);
            const unsigned tg = og / nx;
            if (og + 1u == (tg + 1u) * nx) xb_add(&bar[XB_TOPGEN], 1u);
            else XB_SPIN(xb_ld(&bar[XB_TOPGEN]) == tg);
            __builtin_amdgcn_fence(__ATOMIC_ACQUIRE, "agent");
            xb_add(&bar[XB_XGEN(x)], 1u);
            asm volatile("s_waitcnt vmcnt(0)" ::: "memory");
        } else {
            XB_SPIN(xb_ld(&bar[XB_XGEN(x)]) == gen);
            __builtin_amdgcn_fence(__ATOMIC_ACQUIRE, "agent");
            asm volatile("s_waitcnt vmcnt(0)" ::: "memory");
        }
    }
    __syncthreads();
}

#define SLACK_IDS(nwg_) const int rounds_ = ((nwg_) + G - 1) / G, nfull_ = (nwg_) - (rounds_ - 1) * G; const bool all_ = nfull_ == G; \
        const bool mine_ = all_ || bx >= nfull_; const int tid_ = opaque_tid(wave_s), lane_ = tid_ & 63, wv_ = tid_ >> 6; \
        const int sgw_ = (all_ ? bx : bx - nfull_) * 8 + wv_, sngw_ = (all_ ? G : G - nfull_) * 8; LAS float* sscr_ = (LAS float*)(lds + wv_ * 8704)
#ifndef REP_ATT
#define REP_ATT 1
#endif
#ifndef REP_CACT
#define REP_CACT 1
#endif
#ifndef REP_CONV
#define REP_CONV 1
#endif
#ifndef REP_NORM
#define REP_NORM 1
#endif
struct Args { const float* in[30]; float* out; unsigned char* ws; };
constexpr int LDS_BYTES = 131072 + 64 + 8192 + 8192 + 8192;

__global__ void __launch_bounds__(512, 2) mega_fwd(Args args) {
    extern __shared__ __attribute__((aligned(16))) unsigned char lds_raw[];
    LAS unsigned char* lds = (LAS unsigned char*)lds_raw;
    cg::grid_group grid = cg::this_grid();
#define GSYNC_LIB() do { asm volatile("s_waitcnt vmcnt(0) lgkmcnt(0)" ::: "memory"); grid.sync(); } while (0)
#define GSYNC() xcd_barrier((unsigned*)args.ws, (volatile LAS unsigned*)(lds + 131072), opaque_tid(wave_s))
    const int G = gridDim.x, bx = blockIdx.x;
    const int wave_s = __builtin_amdgcn_readfirstlane((int)(threadIdx.x >> 6));
    const int vcu = (G % 8 == 0) ? (bx % 8) * (G / 8) + bx / 8 : bx;
    unsigned char* ws = args.ws;
    float* out = args.out;
    const float* x = args.in[0]; const int* positions = (const int*)args.in[1];
    bf16_t* XB = (bf16_t*)(ws + WS_XB); unsigned char* BIG = ws + WS_BIG; unsigned char* ACT = ws + WS_ACT;
    float* flog = (float*)(ws + WS_FLOG); float* cum = (float*)(ws + WS_CUM); float* krope = (float*)(ws + WS_KROPE); float* rcs = (float*)(ws + WS_RCS); float* rsn = (float*)(ws + WS_RSN);

    if (threadIdx.x < 2) ((volatile LAS unsigned*)(lds + 131072))[threadIdx.x] = 0u;
    if (blockIdx.x == 0) for (int i = threadIdx.x; i < XCD_BAR_WORDS; i += 512) ((unsigned*)args.ws)[i] = 0u;
    {
        const int tid = opaque_tid(wave_s), lane = tid & 63, wave = tid >> 6, gw = vcu * 8 + wave, NGW = G * 8;
        LAS float* scr = (LAS float*)(lds + wave * 8704);
        for (int i = bx * 512 + tid; i < M_TOK * 32; i += G * 512) {
            const float ang = (float)positions[i >> 5] * exp2f(-(float)(i & 31) * (13.287712379549449f / 32.f));
            const double ad = (double)ang; const double nrev = rint(ad * 0.15915494309189535); const float red = (float)(ad - nrev * 6.283185307179586);
            rcs[i] = __cosf(red); rsn[i] = __sinf(red);
        }
#define CONV(src, gain, dstoff, K, N, Npad) convert_matrix(src, gain, (bf16_t*)(ws + (dstoff)), K, N, Npad, scr, gw, NGW, lane)
        for (int rep_ = 0; rep_ < REP_CONV; ++rep_) {
        CONV(args.in[4], args.in[2] + 0 * DM, W_FOX_IN, 2048, 6160, 6400);
        CONV(args.in[8], nullptr, W_FOX_OUT, 2048, 2048, 2048);
        CONV(args.in[9], args.in[2] + 1 * DM, W_MLA_IN, 2048, 1088, 1280);
        CONV(args.in[12], args.in[10], W_MLA_QB, 512, 3072, 3072);
        CONV(args.in[13], args.in[11], W_MLA_KVB, 512, 4096, 4096);
        CONV(args.in[16], nullptr, W_MLA_OUT, 2048, 2048, 2048);
        for (int l = 0; l < 4; ++l) {
            convert_matrix(args.in[26] + (size_t)l * 2048 * 11264, args.in[3] + l * DM, (bf16_t*)(ws + W_UP + (size_t)l * 44 * MiB), 2048, 11264, 11264, scr, gw, NGW, lane, true);
            if (l < 3) CONV(args.in[29] + (size_t)l * 5632 * 2048, nullptr, W_DOWN + (size_t)l * 22 * MiB, 5632, 2048, 2048);
        }
        }
#undef CONV
        norm_phase(x, XB, (float*)(ws + WS_RSH), vcu, G, wave_s);
    }
    GSYNC_LIB();
    if (threadIdx.x == 0) (void)xb_add(&((unsigned*)args.ws)[XB_XCNT(xb_xcc_id())], 1u);

    for (int layer_ = 0; layer_ < 4; ++layer_) {
        const int layer = opaque_s(layer_);
        unsigned char* ws = opaque_p(args.ws); float* out = opaque_p(args.out);
        const int G = opaque_s((int)gridDim.x), bx = opaque_s((int)blockIdx.x);
        const int vcu = (G % 8 == 0) ? (bx % 8) * (G / 8) + bx / 8 : bx;
        bf16_t* XB = (bf16_t*)(ws + WS_XB); unsigned char* BIG = ws + WS_BIG; unsigned char* ACT = ws + WS_ACT;
            float* flog = (float*)(ws + WS_FLOG); float* cum = (float*)(ws + WS_CUM); float* krope = (float*)(ws + WS_KROPE); float* rcs = (float*)(ws + WS_RCS); float* rsn = (float*)(ws + WS_RSN); float* rsp = (float*)(ws + WS_RSP); float* rssgu = (float*)(ws + WS_RSSGU); float* rsh = (float*)(ws + WS_RSH);
        bf16_t* Obuf = (bf16_t*)ACT;
        const bf16_t* Wout;
        if (layer == 0) {
            bf16_t* QKV = (bf16_t*)BIG; bf16_t* KN = (bf16_t*)(BIG + 192 * MiB); bf16_t* VT = (bf16_t*)(BIG + 288 * MiB);
            { pg8::Gemm g{XB, DM, (const bf16_t*)(ws + W_FOX_IN), DM, M_TOK, 6400, DM}; pg8::StaticOrder S; S.init(M_TOK, 6400, G, bx);
              const int pmb_ = (bx & 7) * 8; pg8::rstd_tab_build(rsh, pmb_, (LAS float*)(lds + 131072 + 64 + 8192), opaque_tid(wave_s));
              pg8::EpiQKV<true> E{QKV, KN, args.in[7], flog, rsh, (LAS float*)(lds + 131072 + 64), (LAS float*)(lds + 131072 + 64 + 8192), pmb_}; pg8::gemm_phase(lds, g, S, E, wave_s); }
            { SLACK_IDS(64 * 25);
              if (mine_) { convert_matrix(args.in[17], args.in[2] + 2 * DM, (bf16_t*)(ws + W_SB_IN), 2048, 6144, 6144, sscr_, sgw_, sngw_, lane_);
                           convert_matrix(args.in[21], args.in[2] + 3 * DM, (bf16_t*)(ws + W_SGU_IN), 2048, 4096, 4096, sscr_, sgw_, sngw_, lane_); } }
            GSYNC();
            for (int rep_ = 0; rep_ < REP_ATT; ++rep_) { kvprep_phase<0>(lds, QKV, KN, VT, args.in[7], flog, args.in[5], cum, nullptr, nullptr, nullptr, vcu, G, wave_s); __syncthreads(); }
            GSYNC();
            for (int rep_ = 0; rep_ < REP_ATT; ++rep_) { attn_phase<0>(lds, QKV, 6144, 128, KN, QKV + 4096, 6144, 128, cum, args.in[6], args.in[7], nullptr, Obuf, vcu, G, wave_s); __syncthreads(); }
            Wout = (const bf16_t*)(ws + W_FOX_OUT);
        } else if (layer == 1) {
            bf16_t* Cb = (bf16_t*)(ACT + 128 * MiB); bf16_t* Qb = (bf16_t*)BIG; bf16_t* KN = (bf16_t*)(BIG + 96 * MiB); bf16_t* VT = nullptr; bf16_t* KV = (bf16_t*)(BIG + 192 * MiB);
            { pg8::Gemm g{XB, DM, (const bf16_t*)(ws + W_MLA_IN), DM, M_TOK, 1280, DM}; pg8::StaticOrder S; S.init(M_TOK, 1280, G, bx);
              const int pmb_ = (bx & 7) * 8; pg8::rstd_tab_build(rsh, pmb_, (LAS float*)(lds + 131072 + 64 + 8192), opaque_tid(wave_s));
              pg8::EpiMlaIn E{Cb, rsp, krope, rsh, (LAS float*)(lds + 131072 + 64 + 8192), pmb_}; pg8::gemm_phase(lds, g, S, E, wave_s); }
            { SLACK_IDS(64 * 5);
              if (mine_) { convert_matrix(args.in[20], nullptr, (bf16_t*)(ws + W_SB_OUT), 2048, 2048, 2048, sscr_, sgw_, sngw_, lane_);
                           convert_matrix(args.in[25], nullptr, (bf16_t*)(ws + W_SGU_OUT), 2048, 2048, 2048, sscr_, sgw_, sngw_, lane_);
                           convert_matrix(args.in[29] + (size_t)3 * 5632 * 2048, nullptr, (bf16_t*)(ws + W_DOWN + (size_t)3 * 22 * MiB), 5632, 2048, 2048, sscr_, sgw_, sngw_, lane_); } }
            GSYNC();
            { pg8::Gemm g{Cb, 1024, (const bf16_t*)(ws + W_MLA_QB), 512, M_TOK, 3072, 512}; pg8::StaticOrder S; S.init(M_TOK, 3072, G, bx);
              pg8::rstd512_tab_build(rsp, (bx & 7) * 8, (LAS float*)(lds + 131072 + 64 + 8192), (LAS float*)(lds + 131072 + 64 + 16384), opaque_tid(wave_s));
              pg8::EpiStore<0, 1, false> E{Qb, 3072, rsp, nullptr, 0, (LAS float*)(lds + 131072 + 64 + 8192), (bx & 7) * 8}; pg8::gemm_phase(lds, g, S, E, wave_s); }
            { pg8::Gemm g{Cb + 512, 1024, (const bf16_t*)(ws + W_MLA_KVB), 512, M_TOK, 4096, 512}; pg8::StaticOrder S; S.init(M_TOK, 4096, G, bx);
              pg8::EpiMlaKV E{KV, KN, args.in[15], rsp + 8, (LAS float*)(lds + 131072 + 64), (LAS float*)(lds + 131072 + 64 + 16384), (bx & 7) * 8}; pg8::gemm_phase(lds, g, S, E, wave_s); }
            kvprep_phase<1>(lds, KV, KN, VT, args.in[15], nullptr, nullptr, nullptr, krope, rcs, rsn, vcu, G, wave_s);
            GSYNC();
            for (int rep_ = 0; rep_ < REP_ATT; ++rep_) { attn_phase<1>(lds, Qb, 3072, 192, KN, KV + 128, 4096, 256, nullptr, args.in[14], rcs, rsn, Obuf, vcu, G, wave_s); __syncthreads(); }
            Wout = (const bf16_t*)(ws + W_MLA_OUT);
        } else if (layer == 2) {
            bf16_t* QKV = (bf16_t*)BIG; bf16_t* KN = (bf16_t*)(BIG + 192 * MiB); bf16_t* VT = (bf16_t*)(BIG + 288 * MiB);
            { pg8::Gemm g{XB, DM, (const bf16_t*)(ws + W_SB_IN), DM, M_TOK, 6144, DM}; pg8::StaticOrder S; S.init(M_TOK, 6144, G, bx);
              const int pmb_ = (bx & 7) * 8; pg8::rstd_tab_build(rsh, pmb_, (LAS float*)(lds + 131072 + 64 + 8192), opaque_tid(wave_s));
              pg8::EpiQKV<false> E{QKV, KN, args.in[19], nullptr, rsh, (LAS float*)(lds + 131072 + 64), (LAS float*)(lds + 131072 + 64 + 8192), pmb_}; pg8::gemm_phase(lds, g, S, E, wave_s); }
            GSYNC();
            for (int rep_ = 0; rep_ < REP_ATT; ++rep_) { attn_phase<2>(lds, QKV, 6144, 128, KN, QKV + 4096, 6144, 128, nullptr, args.in[18], nullptr, nullptr, Obuf, vcu, G, wave_s); __syncthreads(); }
            Wout = (const bf16_t*)(ws + W_SB_OUT);
        } else {
            bf16_t* UV = (bf16_t*)BIG;
            { pg8::Gemm g{XB, DM, (const bf16_t*)(ws + W_SGU_IN), DM, M_TOK, 4096, DM}; pg8::StaticOrder S; S.init(M_TOK, 4096, G, bx);
              const int pmb_ = (bx & 7) * 8; pg8::rstd_tab_build(rsh, pmb_, (LAS float*)(lds + 131072 + 64 + 8192), opaque_tid(wave_s));
              pg8::EpiStore<1, 2, true> E{UV, 4096, rsh, rssgu, 8, (LAS float*)(lds + 131072 + 64 + 8192), pmb_}; pg8::gemm_phase(lds, g, S, E, wave_s); }
            GSYNC();
            for (int rep_ = 0; rep_ < REP_ATT; ++rep_) { sgu_phase(lds, UV, rssgu, args.in[22], args.in[23], args.in[24], Obuf, vcu, G, wave_s); __syncthreads(); }
            Wout = (const bf16_t*)(ws + W_SGU_OUT);
        }
        GSYNC();
        { pg8::Gemm g{Obuf, DM, Wout, DM, M_TOK, DM, DM}; pg8::StaticOrder S; S.init(M_TOK, DM, G, bx);
          if (layer == 0) { pg8::EpiResid<true, false> E{x, out, XB, rsh}; pg8::gemm_phase(lds, g, S, E, wave_s); }
          else { pg8::EpiResid<false, false> E{x, out, XB, rsh}; pg8::gemm_phase(lds, g, S, E, wave_s); } }
        GSYNC();
        bf16_t* AC = (bf16_t*)ACT; float* halo = (float*)(ws + WS_HALO);
        const float* cwl = args.in[27] + (size_t)layer * 3 * 2 * DFF; const float* cbl = args.in[28] + (size_t)layer * 2 * DFF;
        { pg8::Gemm g{XB, DM, (const bf16_t*)(ws + W_UP + (size_t)layer * 44 * MiB), DM, M_TOK, 2 * DFF, DM}; pg8::StaticOrder S; S.init(M_TOK, 2 * DFF, G, bx);
          const int pmb_ = (bx & 7) * 8; pg8::rstd_tab_build(rsh, pmb_, (LAS float*)(lds + 131072 + 64 + 8192), opaque_tid(wave_s));
              pg8::EpiUpConv E{AC, rsh, cwl, cbl, halo, (LAS float*)(lds + 131072 + 64), (LAS float*)(lds + 131072 + 64 + 8192), pmb_}; pg8::gemm_phase(lds, g, S, E, wave_s); }
        GSYNC();
        ffn_fix_phase(halo, cwl, cbl, AC, bx, G, wave_s);
        GSYNC();
        { pg8::Gemm g{AC, DFF, (const bf16_t*)(ws + W_DOWN + (size_t)layer * 22 * MiB), DFF, M_TOK, DM, DFF}; pg8::StaticOrder S; S.init(M_TOK, DM, G, bx);
          if (layer < 3) { pg8::EpiResid<false, false> E{x, out, XB, rsh}; pg8::gemm_phase(lds, g, S, E, wave_s); }
          else { pg8::EpiResid<false, true> E{x, out, XB, rsh}; pg8::gemm_phase(lds, g, S, E, wave_s); } }
        if (layer < 3) GSYNC();
    }
}

extern "C" void kernel_launch(void* const* d_in, const int* in_sizes, int n_in, void* d_out, int out_size, void* d_ws, size_t ws_size, hipStream_t stream) {
    static int grid = 0;
    if (grid == 0) {
        if (n_in != 30 || ws_size < WS_END) { fprintf(stderr, "kernel_launch: unexpected problem (n_in %d, ws %zu)\n", n_in, ws_size); grid = -1; return; }
        int dev = 0, cus = 0, per_cu = 0;
        hipGetDevice(&dev);
        hipDeviceGetAttribute(&cus, hipDeviceAttributeMultiprocessorCount, dev);
        hipFuncSetAttribute((const void*)mega_fwd, hipFuncAttributeMaxDynamicSharedMemorySize, LDS_BYTES);
        hipOccupancyMaxActiveBlocksPerMultiprocessor(&per_cu, (const void*)mega_fwd, 512, LDS_BYTES);
        if (per_cu < 1) { fprintf(stderr, "kernel_launch: occupancy query returned %d\n", per_cu); per_cu = 1; }
        grid = cus * per_cu;
    }
    if (grid < 0) return;
    Args a{};
    for (int i = 0; i < 30; ++i) a.in[i] = (const float*)d_in[i];
    a.out = (float*)d_out; a.ws = (unsigned char*)d_ws;
    void* kargs[] = {&a};
    hipError_t e = hipLaunchCooperativeKernel((const void*)mega_fwd, dim3(grid), dim3(512), kargs, LDS_BYTES, stream);
    if (e != hipSuccess) fprintf(stderr, "cooperative launch failed: %s (grid %d)\n", hipGetErrorString(e), grid);
}
```

```cpp
#include <hip/hip_runtime.h>
#include <hip/hip_cooperative_groups.h>
#include <cstdio>
#include <cstdint>
namespace cg = cooperative_groups;

#define DI __device__ __forceinline__
#define LAS __attribute__((address_space(3)))
typedef unsigned short bf16_t;
typedef short bf16x8 __attribute__((ext_vector_type(8)));
typedef float f32x4 __attribute__((ext_vector_type(4)));
typedef float f32x2 __attribute__((ext_vector_type(2)));
typedef float f32x16 __attribute__((ext_vector_type(16)));
typedef unsigned u32x4 __attribute__((ext_vector_type(4)));
typedef unsigned u32x2 __attribute__((ext_vector_type(2)));
typedef __bf16 bf16x2_t __attribute__((ext_vector_type(2)));
typedef short s16x4 __attribute__((ext_vector_type(4)));

constexpr int M_TOK = 16384, DM = 2048, SEQ = 2048, NH = 16, DFF = 5632;
constexpr float EPS = 1e-6f;
constexpr float LOG2E = 1.4426950408889634f;

DI unsigned pk2(float lo, float hi) { f32x2 v = {lo, hi}; bf16x2_t b = __builtin_convertvector(v, bf16x2_t); return __builtin_bit_cast(unsigned, b); }
DI float bf_lo(unsigned w) { return __uint_as_float(w << 16); }
DI float bf_hi(unsigned w) { return __uint_as_float(w & 0xffff0000u); }
DI float wave_sum(float v) {
#pragma unroll
    for (int o = 1; o < 64; o <<= 1) v += __shfl_xor(v, o);
    return v;
}
DI float fast_rcp(float x) { return __builtin_amdgcn_rcpf(x); }
DI float fast_exp2(float x) { return __builtin_amdgcn_exp2f(x); }
DI float fast_log2(float x) { return __builtin_amdgcn_logf(x); }
DI float gelu_tanh(float x) { const float u = 0.7978845608028654f * (x + 0.044715f * x * x * x); return x * fast_rcp(1.f + fast_exp2(-2.f * LOG2E * u)); }
DI float silu(float x) { return x * fast_rcp(1.f + fast_exp2(-LOG2E * x)); }
#define LDS_WAIT() asm volatile("s_waitcnt lgkmcnt(0)" ::: "memory")
DI int opaque_tid(int wave_s) { unsigned m = ~0u; asm volatile("" : "+s"(m)); int l = (int)__builtin_amdgcn_mbcnt_hi(m, __builtin_amdgcn_mbcnt_lo(m, 0u)); asm volatile("" : "+v"(l)); asm volatile("" : "+s"(wave_s)); return (wave_s << 6) | l; }
DI int opaque_s(int v) { asm volatile("" : "+s"(v)); return v; }
template <class T> DI T* opaque_p(T* p) { asm volatile("" : "+s"(p)); return p; }

namespace pg8 {
constexpr int BM = 256, BK = 64, HALF = 128, HTB = HALF * BK * 2, STAGE_BYTES = 8 * HTB, NXCD = 8, WGM = 8;
__host__ __device__ __forceinline__ int lds_byte(int r, int c) { const int st = (r >> 4) * 2 + (c >> 5), rr = r & 15, cc = c & 31, ob = rr * 64 + cc * 2; return st * 1024 + (ob ^ (((ob >> 9) & 1) << 5)); }
__host__ __device__ __forceinline__ void stage_rc(int b, int& R, int& C) { const int st = b / 1024, sb = b % 1024, swz = sb ^ (((sb >> 9) & 1) << 5); R = (st >> 1) * 16 + swz / 64; C = (st & 1) * 32 + (swz % 64) / 2; }
__host__ __device__ __forceinline__ int perm32(int rho) { const int n = rho >> 4, i = rho & 15; return 8 * (i >> 2) + 4 * n + (i & 3); }

struct Unit { int pm, pn; };
struct Gemm { const bf16_t* A; int lda; const bf16_t* Bt; int ldb; int M, N, K; };

struct StaticOrder {
    int nM, nN, nwg, G, c;
    __host__ __device__ void init(int M, int N, int G_, int c_) { nM = M / BM; nN = N / BM; nwg = nM * nN; G = G_; c = c_; }
    __host__ __device__ bool next(int i, Unit& u) const {
        const long L = (long)i * G + c; if (L >= nwg) return false;
        int wgid = (int)L; { const int q = nwg / NXCD, r = nwg % NXCD, xcd = wgid % NXCD, off = wgid / NXCD; wgid = (xcd < r ? xcd * (q + 1) : r * (q + 1) + (xcd - r) * q) + off; }
        const int nig = WGM * nN, gid = wgid / nig, fm = gid * WGM, gsz = (nM - fm) < WGM ? (nM - fm) : WGM;
        u.pm = fm + ((wgid % nig) % gsz); u.pn = (wgid % nig) / gsz; return true;
    }
};

typedef f32x4 Acc[2][2][4][2];

DI float hrstd(const float* rsh, int r, int fq) {
    const char* rp = (const char*)rsh + (unsigned)((r * 32 + fq * 8) * 4);
    const f32x4 pa = *(const f32x4*)rp, pb = *(const f32x4*)(rp + 16);
    float s = ((pa[0] + pa[1]) + (pa[2] + pa[3])) + ((pb[0] + pb[1]) + (pb[2] + pb[3]));
    s += __shfl_xor(s, 16); s += __shfl_xor(s, 32);
    return __builtin_amdgcn_rsqf(s * (1.f / DM) + EPS);
}
DI float hrstd_t(const float* rsh, LAS const float* tab, int pm_base, int pm, int rl, int fq) {
    if ((unsigned)(pm - pm_base) < 8u) return tab[(pm - pm_base) * 256 + rl];
    return hrstd(rsh, pm * BM + rl, fq);
}
DI void rstd_tab_build(const float* rsh, int pm_base, LAS float* tab, int tid) {
#pragma unroll
    for (int k = 0; k < 4; ++k) {
        const int row = tid + 512 * k; const f32x4* p = (const f32x4*)(rsh + (size_t)(pm_base * BM + row) * 32);
        f32x4 a = p[0] + p[1]; f32x4 b = p[2] + p[3]; f32x4 c = p[4] + p[5]; f32x4 d = p[6] + p[7];
        a = (a + b) + (c + d);
        tab[row] = __builtin_amdgcn_rsqf(((a[0] + a[1]) + (a[2] + a[3])) * (1.f / DM) + EPS);
    }
    __syncthreads();
}
DI void rstd512_tab_build(const float* rsp, int pm_base, LAS float* tq, LAS float* tkv, int tid) {
#pragma unroll
    for (int k = 0; k < 4; ++k) {
        const int row = tid + 512 * k; const f32x4* p = (const f32x4*)(rsp + (size_t)(pm_base * BM + row) * 16);
        const f32x4 a = p[0] + p[1], b = p[2] + p[3];
        tq[row] = __builtin_amdgcn_rsqf(((a[0] + a[1]) + (a[2] + a[3])) * (1.f / 512.f) + EPS);
        tkv[row] = __builtin_amdgcn_rsqf(((b[0] + b[1]) + (b[2] + b[3])) * (1.f / 512.f) + EPS);
    }
    __syncthreads();
}
template <int ACT, int SCALE, bool ACC> struct EpiStore {
    static constexpr bool PERM = true;
    bf16_t* O; int ldc; const float* rs_in; float* rs_out; int acc_pn_lo; LAS const float* tab; int pm_base;
    DI void operator()(const Acc& acc, const Unit& u, int wr, int wc, int fr, int fq) const {
        const int row0 = u.pm * BM + wr * 64 + fr, col0 = u.pn * BM + wc * 32 + 8 * fq;
#pragma unroll
        for (int ai = 0; ai < 2; ++ai)
#pragma unroll
            for (int m = 0; m < 4; ++m) {
                const int r = row0 + ai * HALF + m * 16;
                float sc = 1.f; if (SCALE == 2) sc = hrstd_t(rs_in, tab, pm_base, u.pm, wr * 64 + fr + ai * HALF + m * 16, fq);
                if (SCALE == 1) {
                    if ((unsigned)(u.pm - pm_base) < 8u) sc = tab[(u.pm - pm_base) * 256 + wr * 64 + fr + ai * HALF + m * 16];
                    else { const f32x4 pa = *(const f32x4*)(rs_in + (size_t)r * 16), pb = *(const f32x4*)(rs_in + (size_t)r * 16 + 4);
                        sc = __builtin_amdgcn_rsqf((((pa[0] + pa[1]) + (pa[2] + pa[3])) + ((pb[0] + pb[1]) + (pb[2] + pb[3]))) * (1.f / 512.f) + EPS); } }
                float ss = 0.f;
                bf16_t* rowp = O + (size_t)r * ldc + col0;
#pragma unroll
                for (int bj = 0; bj < 2; ++bj) {
                    f32x4 v0 = acc[ai][bj][m][0], v1 = acc[ai][bj][m][1];
                    if (SCALE) { v0 = v0 * sc; v1 = v1 * sc; }
                    if (ACT == 1) {
#pragma unroll
                        for (int j = 0; j < 4; ++j) { v0[j] = gelu_tanh(v0[j]); v1[j] = gelu_tanh(v1[j]); }
                    }
                    if (ACC) ss += (v0[0] * v0[0] + v0[1] * v0[1]) + (v0[2] * v0[2] + v0[3] * v0[3]) + (v1[0] * v1[0] + v1[1] * v1[1]) + (v1[2] * v1[2] + v1[3] * v1[3]);
                    u32x4 w; w.x = pk2(v0[0], v0[1]); w.y = pk2(v0[2], v0[3]); w.z = pk2(v1[0], v1[1]); w.w = pk2(v1[2], v1[3]);
                    *(u32x4*)(rowp + bj * HALF) = w;
                }
                if (ACC) { if (u.pn >= acc_pn_lo) { ss += __shfl_xor(ss, 16); ss += __shfl_xor(ss, 32); if (fq == 0) rs_out[(size_t)r * 32 + (u.pn - acc_pn_lo) * 4 + wc] = ss; } }
            }
    }
};
template <int DQK_PITCH, int BJ_LO, int BJ_HI, class F>
DI void knorm_store(F v, bf16_t* Kn, const float* kgain, int head0, int head_bj_stride, const Unit& u, int wr, int wc, int fr, int fq, LAS float* xl) {
    const int rl0 = wr * 64 + fr;
#pragma unroll
    for (int ai = 0; ai < 2; ++ai)
#pragma unroll
        for (int m = 0; m < 4; ++m) { const int rl = ai * HALF + rl0 + m * 16;
#pragma unroll
            for (int bj = BJ_LO; bj < BJ_HI; ++bj) { const f32x4 v0 = v(ai, m, bj, 0), v1 = v(ai, m, bj, 1);
                float ss = (v0[0] * v0[0] + v0[1] * v0[1]) + (v0[2] * v0[2] + v0[3] * v0[3]) + (v1[0] * v1[0] + v1[1] * v1[1]) + (v1[2] * v1[2] + v1[3] * v1[3]);
                ss += __shfl_xor(ss, 16); ss += __shfl_xor(ss, 32); if (fq == 0) xl[(rl * 2 + bj) * 4 + wc] = ss; } }
    asm volatile("s_waitcnt lgkmcnt(0)" ::: "memory"); __builtin_amdgcn_s_barrier(); asm volatile("" ::: "memory");
    const f32x4 g0 = *(const f32x4*)(kgain + wc * 32 + 8 * fq), g1 = *(const f32x4*)(kgain + wc * 32 + 8 * fq + 4);
#pragma unroll
    for (int ai = 0; ai < 2; ++ai)
#pragma unroll
        for (int m = 0; m < 4; ++m) { const int rl = ai * HALF + rl0 + m * 16, row = u.pm * BM + rl, b = row >> 11, sq = row & (SEQ - 1);
#pragma unroll
            for (int bj = BJ_LO; bj < BJ_HI; ++bj) { const f32x4 pt = *(const LAS f32x4*)(xl + (rl * 2 + bj) * 4);
                const float r = __builtin_amdgcn_rsqf(((pt[0] + pt[1]) + (pt[2] + pt[3])) * (1.f / 128.f) + EPS);
                const f32x4 v0 = v(ai, m, bj, 0) * r * g0, v1 = v(ai, m, bj, 1) * r * g1;
                u32x4 w; w.x = pk2(v0[0], v0[1]); w.y = pk2(v0[2], v0[3]); w.z = pk2(v1[0], v1[1]); w.w = pk2(v1[2], v1[3]);
                *(u32x4*)(Kn + ((size_t)(b * 16 + head0 + bj * head_bj_stride) * SEQ + sq) * DQK_PITCH + wc * 32 + 8 * fq) = w; } }
}
template <bool FOX> struct EpiQKV {
    static constexpr bool PERM = true;
    bf16_t* O; bf16_t* Kn; const float* kgain; float* flog; const float* rsh; LAS float* xl; LAS const float* tab; int pm_base;
    DI void operator()(const Acc& acc, const Unit& u, int wr, int wc, int fr, int fq) const {
        const int row0 = u.pm * BM + wr * 64 + fr;
        float sc[2][4];
#pragma unroll
        for (int ai = 0; ai < 2; ++ai)
#pragma unroll
            for (int m = 0; m < 4; ++m) sc[ai][m] = hrstd_t(rsh, tab, pm_base, u.pm, wr * 64 + fr + ai * HALF + m * 16, fq);
        if (u.pn >= 8 && u.pn < 16) {
            knorm_store<128, 0, 2>([&](int ai, int m, int bj, int n) { return acc[ai][bj][m][n] * sc[ai][m]; }, Kn, kgain, (u.pn - 8) * 2, 1, u, wr, wc, fr, fq, xl);
        } else if (!FOX || u.pn < 24) {
            const int col0 = u.pn * BM + wc * 32 + 8 * fq;
#pragma unroll
            for (int ai = 0; ai < 2; ++ai)
#pragma unroll
                for (int m = 0; m < 4; ++m) {
                    bf16_t* rowp = O + (size_t)(row0 + ai * HALF + m * 16) * 6144 + col0;
#pragma unroll
                    for (int bj = 0; bj < 2; ++bj) {
                        const f32x4 v0 = acc[ai][bj][m][0] * sc[ai][m], v1 = acc[ai][bj][m][1] * sc[ai][m];
                        u32x4 w; w.x = pk2(v0[0], v0[1]); w.y = pk2(v0[2], v0[3]); w.z = pk2(v1[0], v1[1]); w.w = pk2(v1[2], v1[3]);
                        *(u32x4*)(rowp + bj * HALF) = w;
                    }
                }
        } else if (wc == 0 && fq < 2) {
#pragma unroll
            for (int ai = 0; ai < 2; ++ai)
#pragma unroll
                for (int m = 0; m < 4; ++m) {
                    float* rowp = flog + (size_t)(row0 + ai * HALF + m * 16) * 16 + 8 * fq;
                    *(f32x4*)(rowp) = acc[ai][0][m][0] * sc[ai][m]; *(f32x4*)(rowp + 4) = acc[ai][0][m][1] * sc[ai][m];
                }
        }
    }
};
struct EpiMlaKV {
    static constexpr bool PERM = true;
    bf16_t* KV; bf16_t* Kn; const float* kgain; const float* rs_in; LAS float* xl; LAS const float* tab; int pm_base;
    DI void operator()(const Acc& acc, const Unit& u, int wr, int wc, int fr, int fq) const {
        const int row0 = u.pm * BM + wr * 64 + fr;
        float sc[2][4];
#pragma unroll
        for (int ai = 0; ai < 2; ++ai)
#pragma unroll
            for (int m = 0; m < 4; ++m) { const int r = row0 + ai * HALF + m * 16;
                if ((unsigned)(u.pm - pm_base) < 8u) sc[ai][m] = tab[(u.pm - pm_base) * 256 + wr * 64 + fr + ai * HALF + m * 16];
                else { const f32x4 pa = *(const f32x4*)(rs_in + (size_t)r * 16), pb = *(const f32x4*)(rs_in + (size_t)r * 16 + 4);
                    sc[ai][m] = __builtin_amdgcn_rsqf((((pa[0] + pa[1]) + (pa[2] + pa[3])) + ((pb[0] + pb[1]) + (pb[2] + pb[3]))) * (1.f / 512.f) + EPS); } }
#pragma unroll
        for (int ai = 0; ai < 2; ++ai)
#pragma unroll
            for (int m = 0; m < 4; ++m) {
                const f32x4 v0 = acc[ai][1][m][0] * sc[ai][m], v1 = acc[ai][1][m][1] * sc[ai][m];
                u32x4 w; w.x = pk2(v0[0], v0[1]); w.y = pk2(v0[2], v0[3]); w.z = pk2(v1[0], v1[1]); w.w = pk2(v1[2], v1[3]);
                *(u32x4*)(KV + (size_t)(row0 + ai * HALF + m * 16) * 4096 + u.pn * BM + HALF + wc * 32 + 8 * fq) = w;
            }
        knorm_store<192, 0, 1>([&](int ai, int m, int bj, int n) { return acc[ai][bj][m][n] * sc[ai][m]; }, Kn, kgain, u.pn, 0, u, wr, wc, fr, fq, xl);
    }
};
struct EpiMlaIn {
    static constexpr bool PERM = true;
    bf16_t* O; float* rsp; float* krope; const float* rsh; LAS const float* tab; int pm_base;
    DI void operator()(const Acc& acc, const Unit& u, int wr, int wc, int fr, int fq) const {
        const int row0 = u.pm * BM + wr * 64 + fr;
        float sc[2][4];
#pragma unroll
        for (int ai = 0; ai < 2; ++ai)
#pragma unroll
            for (int m = 0; m < 4; ++m) sc[ai][m] = hrstd_t(rsh, tab, pm_base, u.pm, wr * 64 + fr + ai * HALF + m * 16, fq);
        if (u.pn < 4) {
            const int col0 = u.pn * BM + wc * 32 + 8 * fq;
#pragma unroll
            for (int ai = 0; ai < 2; ++ai)
#pragma unroll
                for (int m = 0; m < 4; ++m) {
                    const int r = row0 + ai * HALF + m * 16;
                    bf16_t* rowp = O + (size_t)r * 1024 + col0; float ss = 0.f;
#pragma unroll
                    for (int bj = 0; bj < 2; ++bj) {
                        const f32x4 v0 = acc[ai][bj][m][0] * sc[ai][m], v1 = acc[ai][bj][m][1] * sc[ai][m];
                        ss += (v0[0] * v0[0] + v0[1] * v0[1]) + (v0[2] * v0[2] + v0[3] * v0[3]) + (v1[0] * v1[0] + v1[1] * v1[1]) + (v1[2] * v1[2] + v1[3] * v1[3]);
                        u32x4 w; w.x = pk2(v0[0], v0[1]); w.y = pk2(v0[2], v0[3]); w.z = pk2(v1[0], v1[1]); w.w = pk2(v1[2], v1[3]);
                        *(u32x4*)(rowp + bj * HALF) = w;
                    }
                    ss += __shfl_xor(ss, 16); ss += __shfl_xor(ss, 32); if (fq == 0) rsp[(size_t)r * 16 + u.pn * 4 + wc] = ss;
                }
        } else if (wc < 2) {
#pragma unroll
            for (int ai = 0; ai < 2; ++ai)
#pragma unroll
                for (int m = 0; m < 4; ++m) {
                    float* rowp = krope + (size_t)(row0 + ai * HALF + m * 16) * 64 + wc * 32 + 8 * fq;
                    *(f32x4*)(rowp) = acc[ai][0][m][0] * sc[ai][m]; *(f32x4*)(rowp + 4) = acc[ai][0][m][1] * sc[ai][m];
                }
        }
    }
};
template <bool BASE_F32, bool OUT_F32> struct EpiResid {
    static constexpr bool PERM = true;
    const float* base; float* out; bf16_t* xb; float* rsh;
    DI void operator()(const Acc& acc, const Unit& u, int wr, int wc, int fr, int fq) const {
        const int row0 = u.pm * BM + wr * 64 + fr, col0 = u.pn * BM + wc * 32 + 8 * fq;
#pragma unroll
        for (int ai = 0; ai < 2; ++ai)
#pragma unroll
            for (int m = 0; m < 4; ++m) {
                const int r = row0 + ai * HALF + m * 16; const size_t off = (size_t)r * DM + col0; float ss = 0.f;
#pragma unroll
                for (int bj = 0; bj < 2; ++bj) {
                    f32x4 v0, v1;
                    if (BASE_F32) { v0 = *(const f32x4*)(base + off + bj * HALF); v1 = *(const f32x4*)(base + off + bj * HALF + 4); }
                    else { const u32x4 b = *(const u32x4*)(xb + off + bj * HALF); v0 = (f32x4){bf_lo(b.x), bf_hi(b.x), bf_lo(b.y), bf_hi(b.y)}; v1 = (f32x4){bf_lo(b.z), bf_hi(b.z), bf_lo(b.w), bf_hi(b.w)}; }
                    v0 = v0 + acc[ai][bj][m][0]; v1 = v1 + acc[ai][bj][m][1];
                    if (OUT_F32) { *(f32x4*)(out + off + bj * HALF) = v0; *(f32x4*)(out + off + bj * HALF + 4) = v1; }
                    else {
                        ss += (v0[0] * v0[0] + v0[1] * v0[1]) + (v0[2] * v0[2] + v0[3] * v0[3]) + (v1[0] * v1[0] + v1[1] * v1[1]) + (v1[2] * v1[2] + v1[3] * v1[3]);
                        u32x4 w; w.x = pk2(v0[0], v0[1]); w.y = pk2(v0[2], v0[3]); w.z = pk2(v1[0], v1[1]); w.w = pk2(v1[2], v1[3]);
                        *(u32x4*)(xb + off + bj * HALF) = w;
                    }
                }
                if (!OUT_F32) { ss += __shfl_xor(ss, 16); ss += __shfl_xor(ss, 32); if (fq == 0) rsh[(size_t)r * 32 + u.pn * 4 + wc] = ss; }
            }
    }
};

DI float dpp_ror1(float v) { return __builtin_bit_cast(float, __builtin_amdgcn_update_dpp(0, __builtin_bit_cast(int, v), 0x121, 0xf, 0xf, false)); }
DI float dpp_ror2(float v) { return __builtin_bit_cast(float, __builtin_amdgcn_update_dpp(0, __builtin_bit_cast(int, v), 0x122, 0xf, 0xf, false)); }
DI unsigned dpp_ror1u(unsigned v) { return (unsigned)__builtin_amdgcn_mov_dpp((int)v, 0x121, 0xf, 0xf, false); }
DI unsigned dpp_ror2u(unsigned v) { return (unsigned)__builtin_amdgcn_mov_dpp((int)v, 0x122, 0xf, 0xf, false); }
DI unsigned dpp_shr1u(unsigned old, unsigned v) { return (unsigned)__builtin_amdgcn_update_dpp((int)old, (int)v, 0x111, 0xf, 0xf, false); }
DI unsigned dpp_shr2u(unsigned old, unsigned v) { return (unsigned)__builtin_amdgcn_update_dpp((int)old, (int)v, 0x112, 0xf, 0xf, false); }
struct EpiUpConv {
    static constexpr bool PERM = true;
    bf16_t* act; const float* rsh; const float* cw; const float* cb; float* halo; LAS float* xl; LAS const float* tab; int pm_base;
    static DI f32x4 conv4(u32x2 cur, u32x2& p1, u32x2& p2, bool f1, bool f2, f32x4 w0, f32x4 w1, f32x4 w2, f32x4 bb) {
        u32x2 s1, s2; s1.x = dpp_shr1u(p1.x, cur.x); s1.y = dpp_shr1u(p1.y, cur.y); s2.x = dpp_shr2u(p2.x, cur.x); s2.y = dpp_shr2u(p2.y, cur.y);
        p1.x = dpp_ror1u(cur.x); p1.y = dpp_ror1u(cur.y); p2.x = dpp_ror2u(cur.x); p2.y = dpp_ror2u(cur.y);
        f32x4 y;
        y[0] = bb[0] + w0[0] * bf_lo(s2.x) + w1[0] * bf_lo(s1.x) + w2[0] * bf_lo(cur.x);
        y[1] = bb[1] + w0[1] * bf_hi(s2.x) + w1[1] * bf_hi(s1.x) + w2[1] * bf_hi(cur.x);
        y[2] = bb[2] + w0[2] * bf_lo(s2.y) + w1[2] * bf_lo(s1.y) + w2[2] * bf_lo(cur.y);
        y[3] = bb[3] + w0[3] * bf_hi(s2.y) + w1[3] * bf_hi(s1.y) + w2[3] * bf_hi(cur.y);
        return y;
    }
    DI void operator()(Acc& acc, const Unit& u, int wr, int wc, int fr, int fq) const {
        asm volatile("" : "+v"(fr), "+v"(fq));
        const int row0 = u.pm * BM + wr * 64 + fr, cl = wc * 32 + 8 * fq;
        f32x4 wg[2][4], wv[2][4];
#pragma unroll
        for (int n = 0; n < 2; ++n) {
            const int cg = u.pn * 128 + cl + 4 * n, cv = DFF + cg;
            const char* gp = (const char*)cw + (unsigned)(cg * 4); const char* vp = (const char*)cw + (unsigned)(cv * 4);
            wg[n][0] = *(const f32x4*)gp; wg[n][1] = *(const f32x4*)(gp + 8 * DFF); wg[n][2] = *(const f32x4*)(gp + 16 * DFF); wg[n][3] = *(const f32x4*)((const char*)cb + (unsigned)(cg * 4));
            wv[n][0] = *(const f32x4*)vp; wv[n][1] = *(const f32x4*)(vp + 8 * DFF); wv[n][2] = *(const f32x4*)(vp + 16 * DFF); wv[n][3] = *(const f32x4*)((const char*)cb + (unsigned)(cv * 4));
        }
        u32x2 pk[2][2][4][2];
        float scv[2][4];
#pragma unroll
        for (int ai = 0; ai < 2; ++ai)
#pragma unroll
            for (int m = 0; m < 4; ++m) scv[ai][m] = hrstd_t(rsh, tab, pm_base, u.pm, wr * 64 + fr + ai * HALF + m * 16, fq);
#pragma unroll
        for (int ai = 0; ai < 2; ++ai)
#pragma unroll
            for (int m = 0; m < 4; ++m) { const float sc = scv[ai][m];
#pragma unroll
                for (int bj = 0; bj < 2; ++bj) {
                    const f32x4 v0 = acc[ai][bj][m][0] * sc, v1 = acc[ai][bj][m][1] * sc;
                    if (m == 3 && fr >= 14) { LAS float* d = xl + ((((ai * 2 + wr) * 2 + bj) * 2 + (fr - 14)) * 128) + cl; *(LAS f32x4*)d = v0; *(LAS f32x4*)(d + 4) = v1; }
                    if (ai == 0 && m == 0 && wr == 0 && fr < 2) { float* d = (float*)((char*)halo + (unsigned)((((u.pm * 2 + bj) * 4 + fr) * DFF + u.pn * 128 + cl) * 4)); *(f32x4*)d = v0; *(f32x4*)(d + 4) = v1; }
                    if (ai == 1 && m == 3 && wr == 1 && fr >= 14) { float* d = (float*)((char*)halo + (unsigned)((((u.pm * 2 + bj) * 4 + 2 + (fr - 14)) * DFF + u.pn * 128 + cl) * 4)); *(f32x4*)d = v0; *(f32x4*)(d + 4) = v1; }
                    pk[ai][bj][m][0].x = pk2(v0[0], v0[1]); pk[ai][bj][m][0].y = pk2(v0[2], v0[3]); pk[ai][bj][m][1].x = pk2(v1[0], v1[1]); pk[ai][bj][m][1].y = pk2(v1[2], v1[3]);
                }
                __builtin_amdgcn_sched_barrier(0); }
        asm volatile("s_waitcnt lgkmcnt(0)" ::: "memory"); __builtin_amdgcn_s_barrier(); asm volatile("" ::: "memory");
        const bool f1 = fr >= 1, f2 = fr >= 2;
#pragma unroll
        for (int n = 0; n < 2; ++n) {
            const int cg = u.pn * 128 + cl + 4 * n;
            const f32x4 g0 = wg[n][0], g1 = wg[n][1], g2 = wg[n][2], gb = wg[n][3], v0 = wv[n][0], v1 = wv[n][1], v2 = wv[n][2], vbb = wv[n][3];
#pragma unroll
            for (int ai = 0; ai < 2; ++ai) {
                const int sg = wr == 1 ? ai * 2 : 1;
                f32x4 bg_ = *(const LAS f32x4*)(xl + (((sg * 2 + 0) * 2 + (fr & 1)) * 128) + cl + 4 * n), bv_ = *(const LAS f32x4*)(xl + (((sg * 2 + 1) * 2 + (fr & 1)) * 128) + cl + 4 * n);
                if ((ai | wr) == 0) { bg_ = (f32x4){0.f, 0.f, 0.f, 0.f}; bv_ = bg_; }
                u32x2 tg, tv; tg.x = pk2(bg_[0], bg_[1]); tg.y = pk2(bg_[2], bg_[3]); tv.x = pk2(bv_[0], bv_[1]); tv.y = pk2(bv_[2], bv_[3]);
                u32x2 pg1, pg2, pv1, pv2; pg1.x = dpp_ror1u(tg.x); pg1.y = dpp_ror1u(tg.y); pg2.x = dpp_ror2u(tg.x); pg2.y = dpp_ror2u(tg.y);
                pv1.x = dpp_ror1u(tv.x); pv1.y = dpp_ror1u(tv.y); pv2.x = dpp_ror2u(tv.x); pv2.y = dpp_ror2u(tv.y);
#pragma unroll
                for (int m = 0; m < 4; ++m) {
                    const f32x4 yv = conv4(pk[ai][1][m][n], pv1, pv2, f1, f2, v0, v1, v2, vbb);
                    const f32x4 yg = conv4(pk[ai][0][m][n], pg1, pg2, f1, f2, g0, g1, g2, gb);
                    u32x2 w; w.x = pk2(silu(yg[0]) * yv[0], silu(yg[1]) * yv[1]); w.y = pk2(silu(yg[2]) * yv[2], silu(yg[3]) * yv[3]);
                    *(u32x2*)((char*)act + (unsigned)(((row0 + ai * HALF + m * 16) * DFF + cg) * 2)) = w;
                    __builtin_amdgcn_sched_barrier(0);
                }
            }
        }
    }
};

template <class Epi, class Sched, bool ALIGN_EPI = true, bool SP2 = true>
DI void gemm_phase(LAS unsigned char* lds, const Gemm g, const Sched& S, const Epi& E, int wave_s) {
    const int tid = opaque_tid(wave_s), wid = __builtin_amdgcn_readfirstlane(tid >> 6), lane = tid & 63, wr = wid >> 2, wc = wid & 3, fr = lane & 15, fq = lane >> 4;
    const int K = g.K, nt = K / BK;
    unsigned voffA[2], voffB[2];
#pragma unroll
    for (int i = 0; i < 2; ++i) { int R, C; stage_rc(tid * 16 + i * 8192, R, C); const int Rb = Epi::PERM ? ((R & ~31) + perm32(R & 31)) : R;
        voffA[i] = (unsigned)(R * g.lda + C) * 2u; voffB[i] = (unsigned)(Rb * g.ldb + C) * 2u; }
    const size_t kstep = (size_t)(BK * 2);
    const size_t hstepA = (size_t)HALF * g.lda * 2, hstepB = (size_t)HALF * g.ldb * 2;
    const size_t tstepA = 2 * hstepA, tstepB = 2 * hstepB;
    const unsigned ldsw = (unsigned)wid * 1024u;
    const int aoff = lds_byte(wr * 64 + fr, fq * 8), boff = lds_byte(wc * 32 + fr, fq * 8);
#define PG8_SA(b, h) (((b) * 2 + (h)) * HTB)
#define PG8_SB(b, h) ((4 + (b) * 2 + (h)) * HTB)
#define PG8_STAGE(bufoff, gbase, voff) do { _Pragma("unroll") for (int _i = 0; _i < 2; ++_i) \
        __builtin_amdgcn_global_load_lds((const unsigned*)((const char*)(gbase) + (voff)[_i]), (LAS unsigned*)(lds + (bufoff) + ldsw + _i * 8192), 16, 0, 0); } while (0)
#define PG8_LDA(dst, b, h) do { _Pragma("unroll") for (int m = 0; m < 4; ++m) _Pragma("unroll") for (int k = 0; k < 2; ++k) dst[m][k] = *(const LAS bf16x8*)(lds + PG8_SA(b, h) + aoff + m * 2048 + k * 1024); } while (0)
#define PG8_LDB(dst, b, h) do { _Pragma("unroll") for (int n = 0; n < 2; ++n) _Pragma("unroll") for (int k = 0; k < 2; ++k) dst[n][k] = *(const LAS bf16x8*)(lds + PG8_SB(b, h) + boff + n * 2048 + k * 1024); } while (0)
#define PG8_MMA(ai, bj, At, Bt) do { __builtin_amdgcn_s_setprio(1); _Pragma("unroll") for (int m = 0; m < 4; ++m) _Pragma("unroll") for (int n = 0; n < 2; ++n) _Pragma("unroll") for (int k = 0; k < 2; ++k) \
        acc[ai][bj][m][n] = __builtin_amdgcn_mfma_f32_16x16x32_bf16(Bt[n][k], At[m][k], acc[ai][bj][m][n], 0, 0, 0); __builtin_amdgcn_s_setprio(0); } while (0)
#define PG8_WAIT_V(n) asm volatile("s_waitcnt vmcnt(" #n ")" ::: "memory")
#define PG8_WAIT_L(n) asm volatile("s_waitcnt lgkmcnt(" #n ")" ::: "memory")
#define PG8_BAR __builtin_amdgcn_s_barrier()
#define PG8_SCHED __builtin_amdgcn_sched_barrier(0)
    Unit cur, nxt; int ui = 0;
    if (!S.next(0, cur)) return;
    f32x4 acc[2][2][4][2];
#pragma unroll
    for (int a = 0; a < 2; ++a)
#pragma unroll
        for (int b = 0; b < 2; ++b)
#pragma unroll
            for (int m = 0; m < 4; ++m)
#pragma unroll
                for (int n = 0; n < 2; ++n) acc[a][b][m][n] = (f32x4){0.f, 0.f, 0.f, 0.f};
    bf16x8 At[4][2], B0[2][2], B1[2][2];
    const char* cA = (const char*)g.A + (size_t)cur.pm * tstepA; const char* cB = (const char*)g.Bt + (size_t)cur.pn * tstepB;
    {
        PG8_STAGE(PG8_SB(0, 0), cB, voffB); PG8_STAGE(PG8_SB(0, 1), cB + hstepB, voffB); PG8_STAGE(PG8_SA(0, 0), cA, voffA); PG8_STAGE(PG8_SA(0, 1), cA + hstepA, voffA);
        if (wr == 1) PG8_BAR;
        PG8_WAIT_V(2); PG8_BAR;
        PG8_STAGE(PG8_SB(1, 0), cB + kstep, voffB); PG8_STAGE(PG8_SA(1, 0), cA + kstep, voffA); PG8_STAGE(PG8_SB(1, 1), cB + hstepB + kstep, voffB);
        PG8_WAIT_V(6); PG8_BAR;
    }
    for (;;) {
        const bool has_next = S.next(ui + 1, nxt);
        const char* nA = has_next ? (const char*)g.A + (size_t)nxt.pm * tstepA : cA; const char* nB = has_next ? (const char*)g.Bt + (size_t)nxt.pn * tstepB : cB;
        for (int t = 0; t < nt; t += 2) {
            const bool last = (t == nt - 2);
            const char* a1 = cA + (size_t)(t + 1) * kstep;
            const char* a2 = last ? nA : cA + (size_t)(t + 2) * kstep; const char* b2 = last ? nB : cB + (size_t)(t + 2) * kstep;
            const char* a3 = a2 + kstep; const char* b3 = b2 + kstep;
            PG8_LDB(B0, 0, 0); PG8_LDB(B1, 0, 1); PG8_SCHED; PG8_LDA(At, 0, 0); PG8_STAGE(PG8_SA(1, 1), a1 + hstepA, voffA);
            PG8_WAIT_V(8); PG8_WAIT_L(0); PG8_BAR; PG8_MMA(0, 0, At, B0); PG8_MMA(0, 1, At, B1); PG8_BAR; PG8_SCHED;
            PG8_LDA(At, 0, 1); PG8_STAGE(PG8_SB(0, 0), b2, voffB); PG8_STAGE(PG8_SB(0, 1), b2 + hstepB, voffB); PG8_STAGE(PG8_SA(0, 0), a2, voffA);
            PG8_WAIT_V(8); PG8_WAIT_L(0); PG8_BAR; PG8_MMA(1, 0, At, B0); PG8_MMA(1, 1, At, B1); PG8_BAR; PG8_SCHED;
            PG8_LDB(B0, 1, 0); PG8_LDB(B1, 1, 1); PG8_SCHED; PG8_LDA(At, 1, 0); PG8_STAGE(PG8_SA(0, 1), a2 + hstepA, voffA);
            PG8_WAIT_V(8); PG8_WAIT_L(0); PG8_BAR; PG8_MMA(0, 0, At, B0); PG8_MMA(0, 1, At, B1); PG8_BAR; PG8_SCHED;
            PG8_LDA(At, 1, 1); PG8_STAGE(PG8_SB(1, 0), b3, voffB); PG8_STAGE(PG8_SB(1, 1), b3 + hstepB, voffB); PG8_STAGE(PG8_SA(1, 0), a3, voffA);
            PG8_WAIT_V(8); PG8_WAIT_L(0); PG8_BAR; PG8_MMA(1, 0, At, B0); PG8_MMA(1, 1, At, B1); PG8_BAR; PG8_SCHED;
        }
        if constexpr (ALIGN_EPI) { if (wr == 0) PG8_BAR; }
        E(acc, cur, wr, wc, fr, fq);
        if (!has_next) break;
#pragma unroll
        for (int a = 0; a < 2; ++a)
#pragma unroll
            for (int b = 0; b < 2; ++b)
#pragma unroll
                for (int m = 0; m < 4; ++m)
#pragma unroll
                    for (int n = 0; n < 2; ++n) acc[a][b][m][n] = (f32x4){0.f, 0.f, 0.f, 0.f};
        cur = nxt; cA = nA; cB = nB; ++ui;
        if constexpr (ALIGN_EPI) { if (wr == 1) PG8_BAR; }
    }
    PG8_WAIT_V(0);
    if constexpr (!ALIGN_EPI) { if (wr == 0) PG8_BAR; }
    PG8_BAR;
#undef PG8_SA
#undef PG8_SB
#undef PG8_STAGE
#undef PG8_LDA
#undef PG8_LDB
#undef PG8_MMA
#undef PG8_WAIT_V
#undef PG8_WAIT_L
#undef PG8_BAR
#undef PG8_SCHED
}
}

constexpr size_t MiB = 1u << 20;
constexpr size_t WS_RSH = 390 * MiB, WS_RSP = 12 * MiB, WS_RSSGU = 13 * MiB;
constexpr size_t WS_FLOG = 1 * MiB, WS_CUM = 2 * MiB, WS_KROPE = 4 * MiB, WS_RCS = 8 * MiB, WS_RSN = 10 * MiB;
constexpr size_t WS_W = 16 * MiB;
constexpr size_t W_FOX_IN = WS_W, W_FOX_OUT = W_FOX_IN + 25 * MiB, W_MLA_IN = W_FOX_OUT + 8 * MiB, W_MLA_QB = W_MLA_IN + 5 * MiB, W_MLA_KVB = W_MLA_QB + 3 * MiB,
                 W_MLA_OUT = W_MLA_KVB + 4 * MiB, W_SB_IN = W_MLA_OUT + 8 * MiB, W_SB_OUT = W_SB_IN + 24 * MiB, W_SGU_IN = W_SB_OUT + 8 * MiB, W_SGU_OUT = W_SGU_IN + 16 * MiB,
                 W_UP = W_SGU_OUT + 8 * MiB, W_DOWN = W_UP + 4 * 44 * MiB, W_END = W_DOWN + 4 * 22 * MiB;
constexpr size_t WS_XB = 400 * MiB, WS_BIG = 464 * MiB, WS_ACT = 816 * MiB, WS_HALO = 992 * MiB, WS_END = 1004 * MiB;
static_assert(W_END <= WS_XB, "weights fit");

DI void convert_matrix(const float* __restrict__ W, const float* __restrict__ gain, bf16_t* __restrict__ WT, int K, int N, int Npad, LAS float* scrf, int gw, int NGW, int lane, bool perm_up = false) {
    LAS unsigned* scr = (LAS unsigned*)scrf;
    const int nblk = Npad / 64, nitems = (K / 64) * nblk;
    const int c = lane & 15, g = lane >> 4;
    for (int it = gw; it < nitems; it += NGW) {
        const int kb = it / nblk, nb = it % nblk, k0 = 64 * kb, n0 = 64 * nb;
        const int n = n0 + 4 * c; const bool ok = n < N;
        const int nd0 = !perm_up ? n0 : (n0 < DFF ? (n0 >> 7) * 256 + (n0 & 127) : ((n0 - DFF) >> 7) * 256 + 128 + ((n0 - DFF) & 127));
        f32x4 v[16];
        const float* wp = W + (size_t)(k0 + 2 * g) * N + n;
#pragma unroll
        for (int j = 0; j < 8; ++j)
#pragma unroll
            for (int e = 0; e < 2; ++e) v[2 * j + e] = ok ? __builtin_nontemporal_load((const f32x4*)(wp + (size_t)(8 * j + e) * N)) : (f32x4){0.f, 0.f, 0.f, 0.f};
        if (gain) {
#pragma unroll
            for (int j = 0; j < 8; ++j) { const f32x2 gg = *(const f32x2*)(gain + k0 + 8 * j + 2 * g); v[2 * j] = v[2 * j] * gg.x; v[2 * j + 1] = v[2 * j + 1] * gg.y; }
        }
#pragma unroll
        for (int j = 0; j < 8; ++j)
#pragma unroll
            for (int q = 0; q < 4; ++q) scr[(4 * c + q) * 33 + 4 * j + g] = pk2(v[2 * j][q], v[2 * j + 1][q]);
        LDS_WAIT();
#pragma unroll
        for (int i = 0; i < 8; ++i) {
            const int nl = (lane >> 3) + 8 * i, q = lane & 7; const LAS unsigned* sp = scr + nl * 33 + 4 * q;
            u32x4 o; o.x = sp[0]; o.y = sp[1]; o.z = sp[2]; o.w = sp[3];
            *(u32x4*)(WT + (size_t)(nd0 + nl) * K + k0 + 8 * q) = o;
        }
        LDS_WAIT();
    }
}

DI void norm_phase(const float* __restrict__ h, bf16_t* __restrict__ xb, float* __restrict__ rsh, int vcu, int G, int wave_s) {
    const int tid = opaque_tid(wave_s), lane = tid & 63, gw = vcu * 8 + (tid >> 6), NGW = G * 8;
    for (int r = gw; r < M_TOK; r += NGW) {
        const f32x4* xr = (const f32x4*)(h + (size_t)r * DM) + lane;
        f32x4 v[8]; float s = 0.f;
#pragma unroll
        for (int j = 0; j < 8; ++j) { v[j] = xr[64 * j]; s += (v[j].x * v[j].x + v[j].y * v[j].y) + (v[j].z * v[j].z + v[j].w * v[j].w); }
        s = wave_sum(s);
        if (lane < 32) rsh[(size_t)r * 32 + lane] = lane == 0 ? s : 0.f;
        u32x2* o = (u32x2*)(xb + (size_t)r * DM) + lane;
#pragma unroll
        for (int j = 0; j < 8; ++j) { u32x2 w; w.x = pk2(v[j].x, v[j].y); w.y = pk2(v[j].z, v[j].w); o[64 * j] = w; }
    }
}

DI void unpack8(const u32x4 w, float* f) { f[0] = bf_lo(w.x); f[1] = bf_hi(w.x); f[2] = bf_lo(w.y); f[3] = bf_hi(w.y); f[4] = bf_lo(w.z); f[5] = bf_hi(w.z); f[6] = bf_lo(w.w); f[7] = bf_hi(w.w); }
template <int MODE>
DI void kvprep_phase(LAS unsigned char* lds, const bf16_t* __restrict__ src, bf16_t* __restrict__ Kn, bf16_t* __restrict__ Vt, const float* __restrict__ kgain,
                     const float* __restrict__ flog, const float* __restrict__ bfp, float* __restrict__ cum, const float* __restrict__ krope, const float* __restrict__ rcs, const float* __restrict__ rsn,
                     int vcu, int G, int wave_s) {
    constexpr int DQK = MODE == 1 ? 192 : 128, LDS_ = MODE == 1 ? 4096 : 6144;
    const int tid = opaque_tid(wave_s), lane = tid & 63, wid = tid >> 6;
    if (MODE == 0) {
        const int gw = vcu * 8 + wid, NGW = G * 8;
        for (int q = gw; q < 128; q += NGW) {
            const int b = q >> 4, h = q & 15; const float bh_ = bfp[h];
            const float* fl = flog + (size_t)(b * SEQ + 32 * lane) * 16 + h;
            float lf[32]; float tot = 0.f;
#pragma unroll
            for (int j = 0; j < 32; ++j) { const float x = fl[j * 16] + bh_; lf[j] = -(fmaxf(-x, 0.f) + 0.6931471805599453f * fast_log2(1.f + fast_exp2(-LOG2E * fabsf(x)))); tot += lf[j]; }
            float incl = tot;
#pragma unroll
            for (int o = 1; o < 64; o <<= 1) { const float y = __shfl_up(incl, o); if (lane >= o) incl += y; }
            float run = incl - tot;
            float* co = cum + (size_t)q * SEQ + 32 * lane;
#pragma unroll
            for (int j = 0; j < 32; j += 4) { f32x4 o4; run += lf[j]; o4[0] = run; run += lf[j + 1]; o4[1] = run; run += lf[j + 2]; o4[2] = run; run += lf[j + 3]; o4[3] = run; *(f32x4*)(co + j) = o4; }
        }
    }
    if (MODE == 1) {
        constexpr int NIT = M_TOK * 16 * 4;
        const int gt = vcu * 512 + tid, GT = G * 512;
        for (int i = gt; i < NIT; i += GT) {
            const int cc = i & 3, h = (i >> 2) & 15, row = i >> 6;
            const float* kr = krope + (size_t)row * 64 + 8 * cc;
            const f32x4 a0 = *(const f32x4*)kr, a1 = *(const f32x4*)(kr + 4), b0 = *(const f32x4*)(kr + 32), b1 = *(const f32x4*)(kr + 36);
            float x1[8] = {a0[0], a0[1], a0[2], a0[3], a1[0], a1[1], a1[2], a1[3]}, x2[8] = {b0[0], b0[1], b0[2], b0[3], b1[0], b1[1], b1[2], b1[3]};
            float s2 = 0.f;
#pragma unroll
            for (int j = 0; j < 8; ++j) s2 += x1[j] * x1[j] + x2[j] * x2[j];
            s2 += __shfl_xor(s2, 1); s2 += __shfl_xor(s2, 2);
            const float rs = __builtin_amdgcn_rsqf(s2 * (1.f / 64.f) + EPS);
            float r1[8], r2[8];
            const f32x4 c0 = *(const f32x4*)(rcs + (size_t)row * 32 + 8 * cc), c1 = *(const f32x4*)(rcs + (size_t)row * 32 + 8 * cc + 4), n0 = *(const f32x4*)(rsn + (size_t)row * 32 + 8 * cc), n1 = *(const f32x4*)(rsn + (size_t)row * 32 + 8 * cc + 4);
#pragma unroll
            for (int j = 0; j < 8; ++j) {
                const int ii = 8 * cc + j;
                const float cs = j < 4 ? c0[j & 3] : c1[j & 3], sn = j < 4 ? n0[j & 3] : n1[j & 3];
                const float y1 = x1[j] * rs * kgain[128 + ii], y2 = x2[j] * rs * kgain[160 + ii];
                r1[j] = y1 * cs - y2 * sn; r2[j] = y1 * sn + y2 * cs;
            }
            const int b = row >> 11, sq = row & (SEQ - 1);
            bf16_t* ro = Kn + ((size_t)(b * 16 + h) * SEQ + sq) * DQK + 128 + 8 * cc;
            u32x4 w1, w2; w1.x = pk2(r1[0], r1[1]); w1.y = pk2(r1[2], r1[3]); w1.z = pk2(r1[4], r1[5]); w1.w = pk2(r1[6], r1[7]);
            w2.x = pk2(r2[0], r2[1]); w2.y = pk2(r2[2], r2[3]); w2.z = pk2(r2[4], r2[5]); w2.w = pk2(r2[6], r2[7]);
            *(u32x4*)ro = w1; *(u32x4*)(ro + 32) = w2;
        }
    }
}

#define MFMA32(a, b, c) __builtin_amdgcn_mfma_f32_32x32x16_bf16((a), (b), (c), 0, 0, 0)
template <int MODE>
DI void attn_phase(LAS unsigned char* lds, const bf16_t* __restrict__ Q, int ldq, int qhs, const bf16_t* __restrict__ Kn, const bf16_t* __restrict__ Vsrc, int ldv, int vhs,
                   const float* __restrict__ cum, const float* qgain, const float* __restrict__ rcs, const float* __restrict__ rsn, bf16_t* __restrict__ O, int vcu, int G, int wave_s) {
    constexpr int DQK = MODE == 1 ? 192 : 128, NST = DQK / 16, KP = DQK * 2 + 16, KBUF = 64 * KP, VP = 272, VBUF = 64 * VP, KCH = DQK / 8, KPT = 64 * KCH / 512;
    constexpr int OFF_V = 2 * KBUF, OFF_C = OFF_V + 3 * VBUF;
    const int tid = opaque_tid(wave_s), lane = tid & 63, w = __builtin_amdgcn_readfirstlane(tid >> 6), r32 = lane & 31, hi = lane >> 5;
    const float CS = (MODE == 1 ? 0.07216878364870322f : 0.08838834764831845f) * LOG2E;
    float fox_thr = 0.f;
    if constexpr (MODE == 0) {
        float gq = fmaxf(fabsf(qgain[lane]), fabsf(qgain[lane + 64])), gk = fmaxf(fabsf(rcs[lane]), fabsf(rcs[lane + 64]));
#pragma unroll
        for (int o = 1; o < 64; o <<= 1) { gq = fmaxf(gq, __shfl_xor(gq, o)); gk = fmaxf(gk, __shfl_xor(gk, o)); }
        fox_thr = 2.02f * (128.f * CS * gq * gk) + 160.f;
    }
    const int pim = (r32 & 0x13) | ((r32 & 4) << 1) | ((r32 & 8) >> 1);
    const unsigned kfo = pim * KP + hi * 16;
    const unsigned vfo = (unsigned)((8 * hi + ((lane & 15) >> 2)) * VP + ((lane >> 4) & 1) * 32 + (lane & 3) * 8);
    for (int g = vcu; g < 512; g += G) {
        const int bh = g >> 2, sub = g & 3, b = bh >> 4, h = bh & 15;
        const bf16_t* Kbh = Kn + (size_t)bh * SEQ * DQK; const bf16_t* Vbh = Vsrc + (size_t)b * SEQ * ldv + h * vhs; const float* cbh = cum + (size_t)bh * SEQ;
        for (int k4 = 0; k4 < 2; ++k4) {
            const int qb = (k4 == 0) ? 7 - sub : sub;
            const int q0 = qb * 256, NT = 4 * (qb + 1);
            int toff = 0;
            if constexpr (MODE == 0) {
                const float cq0 = cbh[q0];
                const bool far_ = lane < NT && (cbh[64 * (lane < NT ? lane : 0) + 63] - cq0) * LOG2E >= fox_thr;
                toff = (int)__popcll(__ballot(far_)); if (toff > NT - 1) toff = NT - 1;
                toff = __builtin_amdgcn_readfirstlane(toff);
            }
            const int NTe = NT - toff;
            const int qmin = q0 + 32 * w, qmax = qmin + 31, qg = qmin + r32;
            bf16x8 qf[NST];
            {
                const float* qgl = qgain; asm volatile("" : "+s"(qgl));
                int r32q = r32, hiq = hi; asm volatile("" : "+v"(r32q), "+v"(hiq));
                const bf16_t* qrow = (Q + (size_t)(b * SEQ + qmin) * ldq + h * qhs) + (unsigned)(r32q * ldq + 8 * hiq);
                u32x4 raw[NST];
#pragma unroll
                for (int st = 0; st < NST; ++st) raw[st] = *(const u32x4*)(qrow + 16 * st);
                float ssn = 0.f;
#pragma unroll
                for (int st = 0; st < 8; ++st) { float f[8]; unpack8(raw[st], f);
#pragma unroll
                    for (int j = 0; j < 8; ++j) ssn += f[j] * f[j]; }
                ssn += __shfl_xor(ssn, 32);
                const float rn = CS / sqrtf(ssn * (1.f / 128.f) + EPS);
#pragma unroll
                for (int st = 0; st < 8; ++st) { float f[8]; unpack8(raw[st], f);
                    const f32x4 g0 = *(const f32x4*)(qgl + 16 * st + 8 * hi), g1 = *(const f32x4*)(qgl + 16 * st + 8 * hi + 4);
                    u32x4 o; o.x = pk2(f[0] * rn * g0[0], f[1] * rn * g0[1]); o.y = pk2(f[2] * rn * g0[2], f[3] * rn * g0[3]);
                    o.z = pk2(f[4] * rn * g1[0], f[5] * rn * g1[1]); o.w = pk2(f[6] * rn * g1[2], f[7] * rn * g1[3]);
                    qf[st] = __builtin_bit_cast(bf16x8, o); }
                if constexpr (MODE == 1) {
                    float ssr = 0.f;
#pragma unroll
                    for (int st = 8; st < 12; ++st) { float f[8]; unpack8(raw[st], f);
#pragma unroll
                        for (int j = 0; j < 8; ++j) ssr += f[j] * f[j]; }
                    ssr += __shfl_xor(ssr, 32);
                    const float rr = 1.0f / sqrtf(ssr * (1.f / 64.f) + EPS);
                    const float* tc = (rcs + (size_t)(b * SEQ + qmin) * 32) + (unsigned)(r32q * 32 + 8 * hiq); const float* tn = (rsn + (size_t)(b * SEQ + qmin) * 32) + (unsigned)(r32q * 32 + 8 * hiq);
#pragma unroll
                    for (int a = 0; a < 2; ++a) {
                        float f1[8], f2[8], o1[8], o2[8]; unpack8(raw[8 + a], f1); unpack8(raw[10 + a], f2);
                        const f32x4 c0 = *(const f32x4*)(tc + 16 * a), c1 = *(const f32x4*)(tc + 16 * a + 4), n0 = *(const f32x4*)(tn + 16 * a), n1 = *(const f32x4*)(tn + 16 * a + 4);
#pragma unroll
                        for (int j = 0; j < 8; ++j) {
                            const int i = 16 * a + 8 * hi + j;
                            const float cs = j < 4 ? c0[j & 3] : c1[j & 3], sn = j < 4 ? n0[j & 3] : n1[j & 3];
                            const float y1 = f1[j] * rr * qgl[128 + i], y2 = f2[j] * rr * qgl[160 + i];
                            o1[j] = (y1 * cs - y2 * sn) * CS; o2[j] = (y1 * sn + y2 * cs) * CS;
                        }
                        u32x4 w1, w2; w1.x = pk2(o1[0], o1[1]); w1.y = pk2(o1[2], o1[3]); w1.z = pk2(o1[4], o1[5]); w1.w = pk2(o1[6], o1[7]);
                        w2.x = pk2(o2[0], o2[1]); w2.y = pk2(o2[2], o2[3]); w2.z = pk2(o2[4], o2[5]); w2.w = pk2(o2[6], o2[7]);
                        qf[8 + a] = __builtin_bit_cast(bf16x8, w1); qf[10 + a] = __builtin_bit_cast(bf16x8, w2);
                    }
                }
            }
            float m_run = -INFINITY, l_run = 0.f, carry = 1.f;
            f32x16 o[4];
#pragma unroll
            for (int d = 0; d < 4; ++d)
#pragma unroll
                for (int i = 0; i < 16; ++i) o[d][i] = 0.f;
            u32x4 kreg[KPT], vreg[2]; float creg = 0.f;
            int tidu = tid; asm volatile("" : "+v"(tidu));
            const unsigned kgo = (unsigned)(tidu * KPT * 16), vgo = (unsigned)(((tidu >> 3) * ldv + (tidu & 7) * 16) * 2);
            const unsigned klo = (unsigned)(((tidu * KPT) / KCH) * KP + ((tidu * KPT) % KCH) * 16), vlo = (unsigned)((tidu >> 3) * VP + (tidu & 7) * 32);
#define ATT_LOAD(t_) do { const int s0_ = (t_) * 64; const char* kg_ = (const char*)(Kbh + (size_t)s0_ * DQK) + kgo; const char* vg_ = (const char*)(Vbh + (size_t)s0_ * ldv) + vgo; \
        _Pragma("unroll") for (int i_ = 0; i_ < KPT; ++i_) kreg[i_] = *(const u32x4*)(kg_ + i_ * 16); \
        _Pragma("unroll") for (int i_ = 0; i_ < 2; ++i_) vreg[i_] = *(const u32x4*)(vg_ + i_ * 16); \
        if (MODE == 0) { if (tid < 64) creg = cbh[s0_ + tid] * LOG2E; } } while (0)
#define ATT_STORE(buf_, vbuf_) do { LAS unsigned char* kb_ = lds + (buf_) * KBUF + klo; \
        _Pragma("unroll") for (int i_ = 0; i_ < KPT; ++i_) *(LAS u32x4*)(kb_ + i_ * 16) = kreg[i_]; \
        LAS unsigned char* vb_ = lds + OFF_V + (vbuf_) * VBUF + vlo; \
        _Pragma("unroll") for (int i_ = 0; i_ < 2; ++i_) *(LAS u32x4*)(vb_ + i_ * 16) = vreg[i_]; \
        if (MODE == 0) { if (tid < 64) ((LAS float*)(lds + OFF_C))[(buf_) * 64 + tid] = creg; } } while (0)
#define ATT_PV(vbi_) do { LAS const unsigned char* vb = lds + OFF_V + (vbi_) * VBUF + vfo; \
        _Pragma("unroll") for (int d = 0; d < 4; ++d) { \
            _Pragma("unroll") for (int s_ = 0; s_ < 4; ++s_) { \
                const s16x4 vlo_ = __builtin_bit_cast(s16x4, __builtin_amdgcn_ds_read_tr16_b64_v4i16((LAS s16x4*)(vb + s_ * 16 * VP + d * 64))); \
                const s16x4 vhi_ = __builtin_bit_cast(s16x4, __builtin_amdgcn_ds_read_tr16_b64_v4i16((LAS s16x4*)(vb + (s_ * 16 + 4) * VP + d * 64))); \
                const bf16x8 vf = __builtin_shufflevector(vlo_, vhi_, 0, 1, 2, 3, 4, 5, 6, 7); \
                o[d] = MFMA32(vf, pf[s_], o[d]); } \
            __builtin_amdgcn_sched_barrier(0); } } while (0)
            const bool late = w >= 4; bool havep = false; int vprev = 0;
            bf16x8 pf[4];
#pragma unroll
            for (int i = 0; i < 4; ++i) pf[i] = (bf16x8){0, 0, 0, 0, 0, 0, 0, 0};
            ATT_LOAD((MODE == 2) ? NT - 1 : toff); ATT_STORE(0, 0); __syncthreads();
            int vcur = 0;
            for (int it = 0; it < NTe; ++it) {
                const int t = (MODE == 2) ? NT - 1 - it : it + toff, tn = (MODE == 2) ? t - 1 : t + 1; const bool more = it + 1 < NTe; const int buf = it & 1;
                if (more) ATT_LOAD(tn);
                if (havep) { ATT_PV(vprev); havep = false; }
                if (64 * t <= qmax) {
                    LAS const unsigned char* kb = lds + buf * KBUF + kfo;
                    f32x16 p0, p1;
#pragma unroll
                    for (int i = 0; i < 16; ++i) { p0[i] = 0.f; p1[i] = 0.f; }
#pragma unroll
                    for (int st = 0; st < NST; ++st) {
                        const bf16x8 k0 = *(LAS const bf16x8*)(kb + st * 32), k1 = *(LAS const bf16x8*)(kb + 32 * KP + st * 32);
                        p0 = MFMA32(k0, qf[st], p0); p1 = MFMA32(k1, qf[st], p1);
                        if ((st & 7) == 7) __builtin_amdgcn_sched_barrier(0);
                    }
                    if constexpr (MODE == 0) {
                        LAS const float* cb = (LAS const float*)(lds + OFF_C) + buf * 64 + 8 * hi;
#pragma unroll
                        for (int a = 0; a < 2; ++a) {
                            const f32x4 c0 = *(LAS const f32x4*)(cb + 16 * a), c1 = *(LAS const f32x4*)(cb + 16 * a + 4), c2 = *(LAS const f32x4*)(cb + 32 + 16 * a), c3 = *(LAS const f32x4*)(cb + 32 + 16 * a + 4);
#pragma unroll
                            for (int j = 0; j < 4; ++j) { p0[8 * a + j] -= c0[j]; p0[8 * a + 4 + j] -= c1[j]; p1[8 * a + j] -= c2[j]; p1[8 * a + 4 + j] -= c3[j]; }
                        }
                    }
                    if (64 * t + 63 >= qmin) {
#pragma unroll
                        for (int i = 0; i < 16; ++i) {
                            const int key = 64 * t + 16 * (i >> 3) + 8 * hi + (i & 7);
                            const bool m0 = (MODE == 2) ? (key >= qg) : (key > qg), m1 = (MODE == 2) ? (key + 32 >= qg) : (key + 32 > qg);
                            if (m0) p0[i] = -INFINITY; if (m1) p1[i] = -INFINITY;
                        }
                    }
                    if constexpr (MODE != 2) {
                        float mx = p0[0];
#pragma unroll
                        for (int i = 1; i < 16; ++i) mx = fmaxf(mx, p0[i]);
#pragma unroll
                        for (int i = 0; i < 16; ++i) mx = fmaxf(mx, p1[i]);
                        mx = fmaxf(mx, __shfl_xor(mx, 32));
                        const float m_new = (MODE == 1) ? ((mx > m_run + 8.f) ? mx : m_run) : fmaxf(m_run, mx);
                        const float alpha = fast_exp2(m_run - m_new);
                        m_run = m_new;
                        float rs = 0.f;
#pragma unroll
                        for (int i = 0; i < 16; ++i) { p0[i] = fast_exp2(p0[i] - m_new); p1[i] = fast_exp2(p1[i] - m_new); rs += p0[i] + p1[i]; }
                        l_run = l_run * alpha + rs;
                        if (!__all(alpha == 1.0f)) {
#pragma unroll
                            for (int d = 0; d < 4; ++d)
#pragma unroll
                                for (int i = 0; i < 16; ++i) o[d][i] *= alpha;
                        }
                    } else {
                        f32x16 l0, l1;
#pragma unroll
                        for (int i = 0; i < 16; ++i) {
                            const float e0_ = fast_exp2(fminf(p0[i], 100.f)), e1_ = fast_exp2(fminf(p1[i], 100.f));
                            l0[i] = fast_rcp(1.f + e0_); l1[i] = fast_rcp(1.f + e1_);
                            p0[i] = e0_ * l0[i]; p1[i] = e1_ * l1[i];
                            if ((i & 3) == 3) __builtin_amdgcn_sched_barrier(0);
                        }
                        __builtin_amdgcn_sched_barrier(0);
                        float own0 = 1.f, own1 = 1.f, own2 = 1.f, own3 = 1.f;
#pragma unroll
                        for (int j = 0; j < 8; ++j) { own0 *= l0[j]; own1 *= l0[8 + j]; own2 *= l1[j]; own3 *= l1[8 + j]; }
                        __builtin_amdgcn_sched_barrier(0);
                        const float oth0 = __shfl_xor(own0, 32), oth1 = __shfl_xor(own1, 32), oth2 = __shfl_xor(own2, 32), oth3 = __shfl_xor(own3, 32);
                        const float so2 = own3, so1 = own3 * own2, so0 = so1 * own1;
                        const float st3 = oth3, st2 = st3 * oth2, st1 = st2 * oth1, st0 = st1 * oth0;
                        const float e0 = carry * so0 * (hi ? st1 : st0), e1 = carry * so1 * (hi ? st2 : st1), e2 = carry * so2 * (hi ? st3 : st2), e3 = carry * (hi ? 1.f : st3);
                        {
                            float run = e0;
#pragma unroll
                            for (int jj = 0; jj < 8; ++jj) { const int i = 7 - jj; p0[i] *= run; run *= l0[i]; }
                            __builtin_amdgcn_sched_barrier(0);
                            run = e1;
#pragma unroll
                            for (int jj = 0; jj < 8; ++jj) { const int i = 15 - jj; p0[i] *= run; run *= l0[i]; }
                            __builtin_amdgcn_sched_barrier(0);
                            run = e2;
#pragma unroll
                            for (int jj = 0; jj < 8; ++jj) { const int i = 7 - jj; p1[i] *= run; run *= l1[i]; }
                            __builtin_amdgcn_sched_barrier(0);
                            run = e3;
#pragma unroll
                            for (int jj = 0; jj < 8; ++jj) { const int i = 15 - jj; p1[i] *= run; run *= l1[i]; }
                        }
                        carry *= so0 * own0 * st0;
                    }
                    { u32x4 w_; w_.x = pk2(p0[0], p0[1]); w_.y = pk2(p0[2], p0[3]); w_.z = pk2(p0[4], p0[5]); w_.w = pk2(p0[6], p0[7]); pf[0] = __builtin_bit_cast(bf16x8, w_);
                      w_.x = pk2(p0[8], p0[9]); w_.y = pk2(p0[10], p0[11]); w_.z = pk2(p0[12], p0[13]); w_.w = pk2(p0[14], p0[15]); pf[1] = __builtin_bit_cast(bf16x8, w_);
                      w_.x = pk2(p1[0], p1[1]); w_.y = pk2(p1[2], p1[3]); w_.z = pk2(p1[4], p1[5]); w_.w = pk2(p1[6], p1[7]); pf[2] = __builtin_bit_cast(bf16x8, w_);
                      w_.x = pk2(p1[8], p1[9]); w_.y = pk2(p1[10], p1[11]); w_.z = pk2(p1[12], p1[13]); w_.w = pk2(p1[14], p1[15]); pf[3] = __builtin_bit_cast(bf16x8, w_); }
                    __builtin_amdgcn_sched_barrier(0);
                    if (late) { havep = true; vprev = vcur; } else { ATT_PV(vcur); }
                }
                const int vnext = vcur == 2 ? 0 : vcur + 1;
                if (more) ATT_STORE(buf ^ 1, vnext);
                vcur = vnext;
                if constexpr (MODE == 2) {
                    const bool dead_w = __all(carry < 1e-37f);
                    if (lane == 0) ((LAS unsigned*)(lds + 131072 - 64))[(it & 1) * 8 + w] = dead_w ? 1u : 0u;
                }
                __syncthreads();
                if constexpr (MODE == 2) {
                    const u32x4 f0 = *(LAS const u32x4*)(lds + 131072 - 64 + (it & 1) * 32), f1 = *(LAS const u32x4*)(lds + 131072 - 64 + (it & 1) * 32 + 16);
                    if ((f0.x & f0.y & f0.z & f0.w & f1.x & f1.y & f1.z & f1.w) != 0u) break;
                }
            }
            if (havep) { ATT_PV(vprev); }
#undef ATT_PV
#undef ATT_LOAD
#undef ATT_STORE
            float inv = 1.f;
            if constexpr (MODE != 2) { const float l = l_run + __shfl_xor(l_run, 32); inv = 1.0f / l; }
            int r32o = r32, hio = hi; asm volatile("" : "+v"(r32o), "+v"(hio));
            bf16_t* orow = (O + (size_t)(b * SEQ + qmin) * DM + h * 128) + (unsigned)(r32o * DM + 4 * hio);
#pragma unroll
            for (int d = 0; d < 4; ++d)
#pragma unroll
                for (int g4 = 0; g4 < 4; ++g4) {
                    u32x2 w_; w_.x = pk2(o[d][4 * g4] * inv, o[d][4 * g4 + 1] * inv); w_.y = pk2(o[d][4 * g4 + 2] * inv, o[d][4 * g4 + 3] * inv);
                    *(u32x2*)(orow + 32 * d + 8 * g4) = w_;
                }
            __syncthreads();
        }
    }
}

DI void sgu_phase(LAS unsigned char* lds, const bf16_t* __restrict__ uv, const float* __restrict__ rowss, const float* __restrict__ vgain, const float* __restrict__ ws,
                  const float* __restrict__ bs, bf16_t* __restrict__ Gout, int vcu, int G, int wave_s) {
    constexpr int AP = 272, OFF_VT = 128 * AP, OFF_RS = 2 * 128 * AP;
    const int tid = opaque_tid(wave_s), lane = tid & 63, w = __builtin_amdgcn_readfirstlane(tid >> 6), r32 = lane & 31, hi = lane >> 5;
    for (int su = vcu; su < 256; su += G) {
        const int g = su >> 4, c0 = (su & 15) * 8;
        __syncthreads();
#pragma unroll
        for (int i = 0; i < 8; ++i) {
            const int ci = tid + 512 * i, t = ci >> 5, s4 = (ci & 31) * 4;
            f32x4 v = *(const f32x4*)(ws + (size_t)g * 16384 + t * 128 + s4);
#pragma unroll
            for (int j = 0; j < 4; ++j) if (s4 + j > t) v[j] = 0.f;
            u32x2 o; o.x = pk2(v[0], v[1]); o.y = pk2(v[2], v[3]);
            *(LAS u32x2*)(lds + t * AP + s4 * 2) = o;
        }
        const int rr = tid >> 2, part = tid & 3;
        u32x4 raw[4]; f32x4 pa, pb;
#define SGU_LOAD(ch_) do { const int rb_ = (c0 + (ch_)) * 128; \
        _Pragma("unroll") for (int i = 0; i < 4; ++i) { const int ci = tid + 512 * i; raw[i] = *(const u32x4*)(uv + (size_t)(rb_ + (ci >> 4)) * 4096 + 2048 + g * 128 + (ci & 15) * 8); } \
        pa = *(const f32x4*)(rowss + (size_t)(rb_ + rr) * 32 + part * 8); pb = *(const f32x4*)(rowss + (size_t)(rb_ + rr) * 32 + part * 8 + 4); } while (0)
        SGU_LOAD(0);
        for (int ch = 0; ch < 8; ++ch) {
            const int rbase = (c0 + ch) * 128;
            __syncthreads();
            {
                float ssum = ((pa[0] + pa[1]) + (pa[2] + pa[3])) + ((pb[0] + pb[1]) + (pb[2] + pb[3]));
                ssum += __shfl_xor(ssum, 1); ssum += __shfl_xor(ssum, 2);
                if (part == 0) ((LAS float*)(lds + OFF_RS))[rr] = __builtin_amdgcn_rsqf(ssum * (1.f / 2048.f) + EPS);
            }
            __syncthreads();
#pragma unroll
            for (int i = 0; i < 4; ++i) {
                const int ci = tid + 512 * i, s_ = ci >> 4, cc = (ci & 15) * 8;
                const float rstd = ((LAS const float*)(lds + OFF_RS))[s_];
                float f[8]; unpack8(raw[i], f);
#pragma unroll
                for (int j = 0; j < 8; j += 2) { const unsigned pw = pk2(f[j] * rstd, f[j + 1] * rstd);
                    *(LAS bf16_t*)(lds + OFF_VT + (cc + j) * AP + s_ * 2) = (bf16_t)(pw & 0xffffu); *(LAS bf16_t*)(lds + OFF_VT + (cc + j + 1) * AP + s_ * 2) = (bf16_t)(pw >> 16); }
            }
            if (ch + 1 < 8) SGU_LOAD(ch + 1);
            const int tb = w >> 1, cb0 = (w & 1) * 2, nsteps = 2 * (tb + 1);
            const int t = 32 * tb + r32; const size_t row = (size_t)rbase + t; const float bias = bs[g * 128 + t];
            u32x2 uu[2][4];
#pragma unroll
            for (int cbk = 0; cbk < 2; ++cbk)
#pragma unroll
                for (int g4 = 0; g4 < 4; ++g4) uu[cbk][g4] = *(const u32x2*)(uv + row * 4096 + g * 128 + 32 * (cb0 + cbk) + 8 * g4 + 4 * hi);
            __syncthreads();
            f32x16 a0, a1;
#pragma unroll
            for (int i = 0; i < 16; ++i) { a0[i] = 0.f; a1[i] = 0.f; }
            LAS const unsigned char* ap = lds + (32 * tb + r32) * AP + hi * 16;
            LAS const unsigned char* vp0 = lds + OFF_VT + (32 * cb0 + r32) * AP + hi * 16;
            for (int st = 0; st < nsteps; ++st) {
                const bf16x8 bf_ = *(LAS const bf16x8*)(ap + st * 32);
                const bf16x8 v0 = *(LAS const bf16x8*)(vp0 + st * 32), v1 = *(LAS const bf16x8*)(vp0 + 32 * AP + st * 32);
                a0 = MFMA32(v0, bf_, a0); a1 = MFMA32(v1, bf_, a1);
            }
#pragma unroll
            for (int cbk = 0; cbk < 2; ++cbk)
#pragma unroll
                for (int g4 = 0; g4 < 4; ++g4) {
                    const int c = 32 * (cb0 + cbk) + 8 * g4 + 4 * hi;
                    const f32x4 vg = *(const f32x4*)(vgain + g * 128 + c);
                    const u32x2 uq = uu[cbk][g4];
                    const float u0 = bf_lo(uq.x), u1 = bf_hi(uq.x), u2 = bf_lo(uq.y), u3 = bf_hi(uq.y);
                    const float m0 = (cbk ? a1[4 * g4] : a0[4 * g4]) * vg[0] + bias, m1 = (cbk ? a1[4 * g4 + 1] : a0[4 * g4 + 1]) * vg[1] + bias;
                    const float m2 = (cbk ? a1[4 * g4 + 2] : a0[4 * g4 + 2]) * vg[2] + bias, m3 = (cbk ? a1[4 * g4 + 3] : a0[4 * g4 + 3]) * vg[3] + bias;
                    u32x2 o; o.x = pk2(u0 * m0, u1 * m1); o.y = pk2(u2 * m2, u3 * m3);
                    *(u32x2*)(Gout + row * DM + g * 128 + c) = o;
                }
        }
#undef SGU_LOAD
    }
    __syncthreads();
}

DI void convact_phase(const bf16_t* __restrict__ up, const float* __restrict__ cw, const float* __restrict__ cbias, bf16_t* __restrict__ act, int bx, int G, int wave_s) {
    const int gtid = bx * 512 + opaque_tid(wave_s), GT = G * 512;
    constexpr int FCH = DFF / 8, RS = 16, NITEMS = (M_TOK / RS) * FCH, LDU = 2 * DFF;
    for (int it = gtid; it < NITEMS; it += GT) {
        const int fc = it % FCH, strip = it / FCH, f0 = fc * 8, r0 = strip * RS;
        float wg[3][8], wv[3][8], bg[8], bv[8];
#pragma unroll
        for (int tp = 0; tp < 3; ++tp) {
            const f32x4 a = *(const f32x4*)(cw + tp * LDU + f0), b = *(const f32x4*)(cw + tp * LDU + f0 + 4), c = *(const f32x4*)(cw + tp * LDU + DFF + f0), d = *(const f32x4*)(cw + tp * LDU + DFF + f0 + 4);
#pragma unroll
            for (int j = 0; j < 4; ++j) { wg[tp][j] = a[j]; wg[tp][4 + j] = b[j]; wv[tp][j] = c[j]; wv[tp][4 + j] = d[j]; }
        }
        {
            const f32x4 a = *(const f32x4*)(cbias + f0), b = *(const f32x4*)(cbias + f0 + 4), c = *(const f32x4*)(cbias + DFF + f0), d = *(const f32x4*)(cbias + DFF + f0 + 4);
#pragma unroll
            for (int j = 0; j < 4; ++j) { bg[j] = a[j]; bg[4 + j] = b[j]; bv[j] = c[j]; bv[4 + j] = d[j]; }
        }
        float g2[8], g1[8], v2[8], v1[8];
        if ((r0 & (SEQ - 1)) == 0) {
#pragma unroll
            for (int j = 0; j < 8; ++j) { g2[j] = 0.f; g1[j] = 0.f; v2[j] = 0.f; v1[j] = 0.f; }
        } else {
            const bf16_t* p2 = up + (size_t)(r0 - 2) * LDU + f0; const bf16_t* p1 = p2 + LDU;
            unpack8(*(const u32x4*)p2, g2); unpack8(*(const u32x4*)(p2 + DFF), v2); unpack8(*(const u32x4*)p1, g1); unpack8(*(const u32x4*)(p1 + DFF), v1);
        }
#pragma unroll 4
        for (int rr = 0; rr < RS; ++rr) {
            const bf16_t* p0 = up + (size_t)(r0 + rr) * LDU + f0;
            float gc[8], vc[8]; unpack8(*(const u32x4*)p0, gc); unpack8(*(const u32x4*)(p0 + DFF), vc);
            float o[8];
#pragma unroll
            for (int j = 0; j < 8; ++j) {
                const float yg = bg[j] + wg[0][j] * g2[j] + wg[1][j] * g1[j] + wg[2][j] * gc[j];
                const float yv = bv[j] + wv[0][j] * v2[j] + wv[1][j] * v1[j] + wv[2][j] * vc[j];
                o[j] = silu(yg) * yv;
                g2[j] = g1[j]; g1[j] = gc[j]; v2[j] = v1[j]; v1[j] = vc[j];
            }
            u32x4 w; w.x = pk2(o[0], o[1]); w.y = pk2(o[2], o[3]); w.z = pk2(o[4], o[5]); w.w = pk2(o[6], o[7]);
            *(u32x4*)(act + (size_t)(r0 + rr) * DFF + f0) = w;
        }
    }
}

DI void ffn_fix_phase(const float* __restrict__ halo, const float* __restrict__ cw, const float* __restrict__ cb, bf16_t* __restrict__ act, int bx, int G, int wave_s) {
    const int gtid = bx * 512 + opaque_tid(wave_s), GT = G * 512;
    constexpr int FQ = DFF / 4, NIT = 56 * FQ;
    for (int it = gtid; it < NIT; it += GT) {
        const int f = (it % FQ) * 4, k = it / FQ, pm = (k / 7) * 8 + 1 + (k % 7);
        f32x4 yr[2][2];
#pragma unroll
        for (int bj = 0; bj < 2; ++bj) {
            const float* hp = halo + ((size_t)((pm - 1) * 2 + bj) * 4) * DFF + f; const float* hc = halo + ((size_t)(pm * 2 + bj) * 4) * DFF + f;
            const f32x4 a2 = *(const f32x4*)(hp + 2 * DFF), a1 = *(const f32x4*)(hp + 3 * DFF), c0 = *(const f32x4*)hc, c1 = *(const f32x4*)(hc + DFF);
            const int c = bj * DFF + f;
            const f32x4 w0 = *(const f32x4*)(cw + c), w1 = *(const f32x4*)(cw + 2 * DFF + c), w2 = *(const f32x4*)(cw + 4 * DFF + c), bb = *(const f32x4*)(cb + c);
            yr[bj][0] = bb + w0 * a2 + w1 * a1 + w2 * c0; yr[bj][1] = bb + w0 * a1 + w1 * c0 + w2 * c1;
        }
#pragma unroll
        for (int rr = 0; rr < 2; ++rr) { u32x2 w; w.x = pk2(silu(yr[0][rr][0]) * yr[1][rr][0], silu(yr[0][rr][1]) * yr[1][rr][1]); w.y = pk2(silu(yr[0][rr][2]) * yr[1][rr][2], silu(yr[0][rr][3]) * yr[1][rr][3]);
            *(u32x2*)(act + (size_t)(pm * 256 + rr) * DFF + f) = w; }
    }
}

#define XB_XCNT(j)  (256  + 64 * (j))
#define XB_XSUB(j)  (1280 + 64 * (j))
#define XB_XGEN(j)  (2304 + 64 * (j))
#define XB_TOP      3328
#define XB_TOPGEN   3392
#define XCD_BAR_WORDS 3456
DI unsigned xb_ld(unsigned* p) { return __hip_atomic_load(p, __ATOMIC_RELAXED, __HIP_MEMORY_SCOPE_AGENT); }
DI unsigned xb_add(unsigned* p, unsigned v) { return __hip_atomic_fetch_add(p, v, __ATOMIC_RELAXED, __HIP_MEMORY_SCOPE_AGENT); }
DI unsigned xb_xcc_id() { return (unsigned)__builtin_amdgcn_s_getreg((3 << 11) | 20) & 0xFu; }
#define XB_SPIN(cond) do { unsigned _sp = 0; while (cond) { __builtin_amdgcn_s_sleep(1); if (++_sp > (1u << 24)) break; } } while (0)
DI void xcd_barrier(unsigned* bar, volatile LAS unsigned* st, int tid) {
    asm volatile("s_waitcnt vmcnt(0) lgkmcnt(0)" ::: "memory");
    __syncthreads();
    if (tid == 0) {
        const unsigned x = xb_xcc_id();
        unsigned nloc = st[0], nx = st[1];
        if (nloc == 0u) {
            const unsigned G = gridDim.x; unsigned sp = 0;
            for (;;) {
                unsigned sum = 0u, cnt = 0u, mine = 0u;
#pragma unroll
                for (unsigned j = 0; j < 16; ++j) { const unsigned c = xb_ld(&bar[XB_XCNT(j)]); sum += c; cnt += (c > 0u) ? 1u : 0u; mine = (j == x) ? c : mine; }
                nloc = mine > 0u ? mine : 1u; nx = cnt > 0u ? cnt : 1u;
                if (sum == G) break;
                __builtin_amdgcn_s_sleep(1); if (++sp > (1u << 22)) break;
            }
            st[0] = nloc; st[1] = nx;
        }
        const unsigned old = xb_add(&bar[XB_XSUB(x)], 1u);
        const unsigned gen = old / nloc;
        if (old + 1u == (gen + 1u) * nloc) {
            __builtin_amdgcn_fence(__ATOMIC_RELEASE, "agent");
            asm volatile("s_waitcnt vmcnt(0)" ::: "memory");
            const unsigned og = xb_add(&bar[XB_TOP], 1u);
            const unsigned tg = og / nx;
            if (og + 1u == (tg + 1u) * nx) xb_add(&bar[XB_TOPGEN], 1u);
            else XB_SPIN(xb_ld(&bar[XB_TOPGEN]) == tg);
            __builtin_amdgcn_fence(__ATOMIC_ACQUIRE, "agent");
            xb_add(&bar[XB_XGEN(x)], 1u);
            asm volatile("s_waitcnt vmcnt(0)" ::: "memory");
        } else {
            XB_SPIN(xb_ld(&bar[XB_XGEN(x)]) == gen);
            __builtin_amdgcn_fence(__ATOMIC_ACQUIRE, "agent");
            asm volatile("s_waitcnt vmcnt(0)" ::: "memory");
        }
    }
    __syncthreads();
}

#define SLACK_IDS(nwg_) const int rounds_ = ((nwg_) + G - 1) / G, nfull_ = (nwg_) - (rounds_ - 1) * G; const bool all_ = nfull_ == G; \
        const bool mine_ = all_ || bx >= nfull_; const int tid_ = opaque_tid(wave_s), lane_ = tid_ & 63, wv_ = tid_ >> 6; \
        const int sgw_ = (all_ ? bx : bx - nfull_) * 8 + wv_, sngw_ = (all_ ? G : G - nfull_) * 8; LAS float* sscr_ = (LAS float*)(lds + wv_ * 8704)
#ifndef REP_ATT
#define REP_ATT 1
#endif
#ifndef REP_CACT
#define REP_CACT 1
#endif
#ifndef REP_CONV
#define REP_CONV 1
#endif
#ifndef REP_NORM
#define REP_NORM 1
#endif
struct Args { const float* in[30]; float* out; unsigned char* ws; };
constexpr int LDS_BYTES = 131072 + 64 + 8192 + 8192 + 8192;

__global__ void __launch_bounds__(512, 2) mega_fwd(Args args) {
    extern __shared__ __attribute__((aligned(16))) unsigned char lds_raw[];
    LAS unsigned char* lds = (LAS unsigned char*)lds_raw;
    cg::grid_group grid = cg::this_grid();
#define GSYNC_LIB() do { asm volatile("s_waitcnt vmcnt(0) lgkmcnt(0)" ::: "memory"); grid.sync(); } while (0)
#define GSYNC() xcd_barrier((unsigned*)args.ws, (volatile LAS unsigned*)(lds + 131072), opaque_tid(wave_s))
    const int G = gridDim.x, bx = blockIdx.x;
    const int wave_s = __builtin_amdgcn_readfirstlane((int)(threadIdx.x >> 6));
    const int vcu = (G % 8 == 0) ? (bx % 8) * (G / 8) + bx / 8 : bx;
    unsigned char* ws = args.ws;
    float* out = args.out;
    const float* x = args.in[0]; const int* positions = (const int*)args.in[1];
    bf16_t* XB = (bf16_t*)(ws + WS_XB); unsigned char* BIG = ws + WS_BIG; unsigned char* ACT = ws + WS_ACT;
    float* flog = (float*)(ws + WS_FLOG); float* cum = (float*)(ws + WS_CUM); float* krope = (float*)(ws + WS_KROPE); float* rcs = (float*)(ws + WS_RCS); float* rsn = (float*)(ws + WS_RSN);

    if (threadIdx.x < 2) ((volatile LAS unsigned*)(lds + 131072))[threadIdx.x] = 0u;
    if (blockIdx.x == 0) for (int i = threadIdx.x; i < XCD_BAR_WORDS; i += 512) ((unsigned*)args.ws)[i] = 0u;
    {
        const int tid = opaque_tid(wave_s), lane = tid & 63, wave = tid >> 6, gw = vcu * 8 + wave, NGW = G * 8;
        LAS float* scr = (LAS float*)(lds + wave * 8704);
        for (int i = bx * 512 + tid; i < M_TOK * 32; i += G * 512) {
            const float ang = (float)positions[i >> 5] * exp2f(-(float)(i & 31) * (13.287712379549449f / 32.f));
            const double ad = (double)ang; const double nrev = rint(ad * 0.15915494309189535); const float red = (float)(ad - nrev * 6.283185307179586);
            rcs[i] = __cosf(red); rsn[i] = __sinf(red);
        }
#define CONV(src, gain, dstoff, K, N, Npad) convert_matrix(src, gain, (bf16_t*)(ws + (dstoff)), K, N, Npad, scr, gw, NGW, lane)
        for (int rep_ = 0; rep_ < REP_CONV; ++rep_) {
        CONV(args.in[4], args.in[2] + 0 * DM, W_FOX_IN, 2048, 6160, 6400);
        CONV(args.in[8], nullptr, W_FOX_OUT, 2048, 2048, 2048);
        CONV(args.in[9], args.in[2] + 1 * DM, W_MLA_IN, 2048, 1088, 1280);
        CONV(args.in[12], args.in[10], W_MLA_QB, 512, 3072, 3072);
        CONV(args.in[13], args.in[11], W_MLA_KVB, 512, 4096, 4096);
        CONV(args.in[16], nullptr, W_MLA_OUT, 2048, 2048, 2048);
        for (int l = 0; l < 4; ++l) {
            convert_matrix(args.in[26] + (size_t)l * 2048 * 11264, args.in[3] + l * DM, (bf16_t*)(ws + W_UP + (size_t)l * 44 * MiB), 2048, 11264, 11264, scr, gw, NGW, lane, true);
            if (l < 3) CONV(args.in[29] + (size_t)l * 5632 * 2048, nullptr, W_DOWN + (size_t)l * 22 * MiB, 5632, 2048, 2048);
        }
        }
#undef CONV
        norm_phase(x, XB, (float*)(ws + WS_RSH), vcu, G, wave_s);
    }
    GSYNC_LIB();
    if (threadIdx.x == 0) (void)xb_add(&((unsigned*)args.ws)[XB_XCNT(xb_xcc_id())], 1u);

    for (int layer_ = 0; layer_ < 4; ++layer_) {
        const int layer = opaque_s(layer_);
        unsigned char* ws = opaque_p(args.ws); float* out = opaque_p(args.out);
        const int G = opaque_s((int)gridDim.x), bx = opaque_s((int)blockIdx.x);
        const int vcu = (G % 8 == 0) ? (bx % 8) * (G / 8) + bx / 8 : bx;
        bf16_t* XB = (bf16_t*)(ws + WS_XB); unsigned char* BIG = ws + WS_BIG; unsigned char* ACT = ws + WS_ACT;
            float* flog = (float*)(ws + WS_FLOG); float* cum = (float*)(ws + WS_CUM); float* krope = (float*)(ws + WS_KROPE); float* rcs = (float*)(ws + WS_RCS); float* rsn = (float*)(ws + WS_RSN); float* rsp = (float*)(ws + WS_RSP); float* rssgu = (float*)(ws + WS_RSSGU); float* rsh = (float*)(ws + WS_RSH);
        bf16_t* Obuf = (bf16_t*)ACT;
        const bf16_t* Wout;
        if (layer == 0) {
            bf16_t* QKV = (bf16_t*)BIG; bf16_t* KN = (bf16_t*)(BIG + 192 * MiB); bf16_t* VT = (bf16_t*)(BIG + 288 * MiB);
            { pg8::Gemm g{XB, DM, (const bf16_t*)(ws + W_FOX_IN), DM, M_TOK, 6400, DM}; pg8::StaticOrder S; S.init(M_TOK, 6400, G, bx);
              const int pmb_ = (bx & 7) * 8; pg8::rstd_tab_build(rsh, pmb_, (LAS float*)(lds + 131072 + 64 + 8192), opaque_tid(wave_s));
              pg8::EpiQKV<true> E{QKV, KN, args.in[7], flog, rsh, (LAS float*)(lds + 131072 + 64), (LAS float*)(lds + 131072 + 64 + 8192), pmb_}; pg8::gemm_phase(lds, g, S, E, wave_s); }
            { SLACK_IDS(64 * 25);
              if (mine_) { convert_matrix(args.in[17], args.in[2] + 2 * DM, (bf16_t*)(ws + W_SB_IN), 2048, 6144, 6144, sscr_, sgw_, sngw_, lane_);
                           convert_matrix(args.in[21], args.in[2] + 3 * DM, (bf16_t*)(ws + W_SGU_IN), 2048, 4096, 4096, sscr_, sgw_, sngw_, lane_); } }
            GSYNC();
            for (int rep_ = 0; rep_ < REP_ATT; ++rep_) { kvprep_phase<0>(lds, QKV, KN, VT, args.in[7], flog, args.in[5], cum, nullptr, nullptr, nullptr, vcu, G, wave_s); __syncthreads(); }
            GSYNC();
            for (int rep_ = 0; rep_ < REP_ATT; ++rep_) { attn_phase<0>(lds, QKV, 6144, 128, KN, QKV + 4096, 6144, 128, cum, args.in[6], args.in[7], nullptr, Obuf, vcu, G, wave_s); __syncthreads(); }
            Wout = (const bf16_t*)(ws + W_FOX_OUT);
        } else if (layer == 1) {
            bf16_t* Cb = (bf16_t*)(ACT + 128 * MiB); bf16_t* Qb = (bf16_t*)BIG; bf16_t* KN = (bf16_t*)(BIG + 96 * MiB); bf16_t* VT = nullptr; bf16_t* KV = (bf16_t*)(BIG + 192 * MiB);
            { pg8::Gemm g{XB, DM, (const bf16_t*)(ws + W_MLA_IN), DM, M_TOK, 1280, DM}; pg8::StaticOrder S; S.init(M_TOK, 1280, G, bx);
              const int pmb_ = (bx & 7) * 8; pg8::rstd_tab_build(rsh, pmb_, (LAS float*)(lds + 131072 + 64 + 8192), opaque_tid(wave_s));
              pg8::EpiMlaIn E{Cb, rsp, krope, rsh, (LAS float*)(lds + 131072 + 64 + 8192), pmb_}; pg8::gemm_phase(lds, g, S, E, wave_s); }
            { SLACK_IDS(64 * 5);
              if (mine_) { convert_matrix(args.in[20], nullptr, (bf16_t*)(ws + W_SB_OUT), 2048, 2048, 2048, sscr_, sgw_, sngw_, lane_);
                           convert_matrix(args.in[25], nullptr, (bf16_t*)(ws + W_SGU_OUT), 2048, 2048, 2048, sscr_, sgw_, sngw_, lane_);
                           convert_matrix(args.in[29] + (size_t)3 * 5632 * 2048, nullptr, (bf16_t*)(ws + W_DOWN + (size_t)3 * 22 * MiB), 5632, 2048, 2048, sscr_, sgw_, sngw_, lane_); } }
            GSYNC();
            { pg8::Gemm g{Cb, 1024, (const bf16_t*)(ws + W_MLA_QB), 512, M_TOK, 3072, 512}; pg8::StaticOrder S; S.init(M_TOK, 3072, G, bx);
              pg8::rstd512_tab_build(rsp, (bx & 7) * 8, (LAS float*)(lds + 131072 + 64 + 8192), (LAS float*)(lds + 131072 + 64 + 16384), opaque_tid(wave_s));
              pg8::EpiStore<0, 1, false> E{Qb, 3072, rsp, nullptr, 0, (LAS float*)(lds + 131072 + 64 + 8192), (bx & 7) * 8}; pg8::gemm_phase(lds, g, S, E, wave_s); }
            { pg8::Gemm g{Cb + 512, 1024, (const bf16_t*)(ws + W_MLA_KVB), 512, M_TOK, 4096, 512}; pg8::StaticOrder S; S.init(M_TOK, 4096, G, bx);
              pg8::EpiMlaKV E{KV, KN, args.in[15], rsp + 8, (LAS float*)(lds + 131072 + 64), (LAS float*)(lds + 131072 + 64 + 16384), (bx & 7) * 8}; pg8::gemm_phase(lds, g, S, E, wave_s); }
            kvprep_phase<1>(lds, KV, KN, VT, args.in[15], nullptr, nullptr, nullptr, krope, rcs, rsn, vcu, G, wave_s);
            GSYNC();
            for (int rep_ = 0; rep_ < REP_ATT; ++rep_) { attn_phase<1>(lds, Qb, 3072, 192, KN, KV + 128, 4096, 256, nullptr, args.in[14], rcs, rsn, Obuf, vcu, G, wave_s); __syncthreads(); }
            Wout = (const bf16_t*)(ws + W_MLA_OUT);
        } else if (layer == 2) {
            bf16_t* QKV = (bf16_t*)BIG; bf16_t* KN = (bf16_t*)(BIG + 192 * MiB); bf16_t* VT = (bf16_t*)(BIG + 288 * MiB);
            { pg8::Gemm g{XB, DM, (const bf16_t*)(ws + W_SB_IN), DM, M_TOK, 6144, DM}; pg8::StaticOrder S; S.init(M_TOK, 6144, G, bx);
              const int pmb_ = (bx & 7) * 8; pg8::rstd_tab_build(rsh, pmb_, (LAS float*)(lds + 131072 + 64 + 8192), opaque_tid(wave_s));
              pg8::EpiQKV<false> E{QKV, KN, args.in[19], nullptr, rsh, (LAS float*)(lds + 131072 + 64), (LAS float*)(lds + 131072 + 64 + 8192), pmb_}; pg8::gemm_phase(lds, g, S, E, wave_s); }
            GSYNC();
            for (int rep_ = 0; rep_ < REP_ATT; ++rep_) { attn_phase<2>(lds, QKV, 6144, 128, KN, QKV + 4096, 6144, 128, nullptr, args.in[18], nullptr, nullptr, Obuf, vcu, G, wave_s); __syncthreads(); }
            Wout = (const bf16_t*)(ws + W_SB_OUT);
        } else {
            bf16_t* UV = (bf16_t*)BIG;
            { pg8::Gemm g{XB, DM, (const bf16_t*)(ws + W_SGU_IN), DM, M_TOK, 4096, DM}; pg8::StaticOrder S; S.init(M_TOK, 4096, G, bx);
              const int pmb_ = (bx & 7) * 8; pg8::rstd_tab_build(rsh, pmb_, (LAS float*)(lds + 131072 + 64 + 8192), opaque_tid(wave_s));
              pg8::EpiStore<1, 2, true> E{UV, 4096, rsh, rssgu, 8, (LAS float*)(lds + 131072 + 64 + 8192), pmb_}; pg8::gemm_phase(lds, g, S, E, wave_s); }
            GSYNC();
            for (int rep_ = 0; rep_ < REP_ATT; ++rep_) { sgu_phase(lds, UV, rssgu, args.in[22], args.in[23], args.in[24], Obuf, vcu, G, wave_s); __syncthreads(); }
            Wout = (const bf16_t*)(ws + W_SGU_OUT);
        }
        GSYNC();
        { pg8::Gemm g{Obuf, DM, Wout, DM, M_TOK, DM, DM}; pg8::StaticOrder S; S.init(M_TOK, DM, G, bx);
          if (layer == 0) { pg8::EpiResid<true, false> E{x, out, XB, rsh}; pg8::gemm_phase(lds, g, S, E, wave_s); }
          else { pg8::EpiResid<false, false> E{x, out, XB, rsh}; pg8::gemm_phase(lds, g, S, E, wave_s); } }
        GSYNC();
        bf16_t* AC = (bf16_t*)ACT; float* halo = (float*)(ws + WS_HALO);
        const float* cwl = args.in[27] + (size_t)layer * 3 * 2 * DFF; const float* cbl = args.in[28] + (size_t)layer * 2 * DFF;
        { pg8::Gemm g{XB, DM, (const bf16_t*)(ws + W_UP + (size_t)layer * 44 * MiB), DM, M_TOK, 2 * DFF, DM}; pg8::StaticOrder S; S.init(M_TOK, 2 * DFF, G, bx);
          const int pmb_ = (bx & 7) * 8; pg8::rstd_tab_build(rsh, pmb_, (LAS float*)(lds + 131072 + 64 + 8192), opaque_tid(wave_s));
              pg8::EpiUpConv E{AC, rsh, cwl, cbl, halo, (LAS float*)(lds + 131072 + 64), (LAS float*)(lds + 131072 + 64 + 8192), pmb_}; pg8::gemm_phase(lds, g, S, E, wave_s); }
        GSYNC();
        ffn_fix_phase(halo, cwl, cbl, AC, bx, G, wave_s);
        GSYNC();
        { pg8::Gemm g{AC, DFF, (const bf16_t*)(ws + W_DOWN + (size_t)layer * 22 * MiB), DFF, M_TOK, DM, DFF}; pg8::StaticOrder S; S.init(M_TOK, DM, G, bx);
          if (layer < 3) { pg8::EpiResid<false, false> E{x, out, XB, rsh}; pg8::gemm_phase(lds, g, S, E, wave_s); }
          else { pg8::EpiResid<false, true> E{x, out, XB, rsh}; pg8::gemm_phase(lds, g, S, E, wave_s); } }
        if (layer < 3) GSYNC();
    }
}

extern "C" void kernel_launch(void* const* d_in, const int* in_sizes, int n_in, void* d_out, int out_size, void* d_ws, size_t ws_size, hipStream_t stream) {
    static int grid = 0;
    if (grid == 0) {
        if (n_in != 30 || ws_size < WS_END) { fprintf(stderr, "kernel_launch: unexpected problem (n_in %d, ws %zu)\n", n_in, ws_size); grid = -1; return; }
        int dev = 0, cus = 0, per_cu = 0;
        hipGetDevice(&dev);
        hipDeviceGetAttribute(&cus, hipDeviceAttributeMultiprocessorCount, dev);
        hipFuncSetAttribute((const void*)mega_fwd, hipFuncAttributeMaxDynamicSharedMemorySize, LDS_BYTES);
        hipOccupancyMaxActiveBlocksPerMultiprocessor(&per_cu, (const void*)mega_fwd, 512, LDS_BYTES);
        if (per_cu < 1) { fprintf(stderr, "kernel_launch: occupancy query returned %d\n", per_cu); per_cu = 1; }
        grid = cus * per_cu;
    }
    if (grid < 0) return;
    Args a{};
    for (int i = 0; i < 30; ++i) a.in[i] = (const float*)d_in[i];
    a.out = (float*)d_out; a.ws = (unsigned char*)d_ws;
    void* kargs[] = {&a};
    hipError_t e = hipLaunchCooperativeKernel((const void*)mega_fwd, dim3(grid), dim3(512), kargs, LDS_BYTES, stream);
    if (e != hipSuccess) fprintf(stderr, "cooperative launch failed: %s (grid %d)\n", hipGetErrorString(e), grid);
}
```

```cpp
#include <hip/hip_runtime.h>
#include <hip/hip_cooperative_groups.h>
#include <cstdio>
#include <cstdint>
namespace cg = cooperative_groups;

#define DI __device__ __forceinline__
#define LAS __attribute__((address_space(3)))
typedef unsigned short bf16_t;
typedef short bf16x8 __attribute__((ext_vector_type(8)));
typedef float f32x4 __attribute__((ext_vector_type(4)));
typedef float f32x2 __attribute__((ext_vector_type(2)));
typedef float f32x16 __attribute__((ext_vector_type(16)));
typedef unsigned u32x4 __attribute__((ext_vector_type(4)));
typedef unsigned u32x2 __attribute__((ext_vector_type(2)));
typedef __bf16 bf16x2_t __attribute__((ext_vector_type(2)));
typedef short s16x4 __attribute__((ext_vector_type(4)));

constexpr int M_TOK = 16384, DM = 2048, SEQ = 2048, NH = 16, DFF = 5632;
constexpr float EPS = 1e-6f;
constexpr float LOG2E = 1.4426950408889634f;

DI unsigned pk2(float lo, float hi) { f32x2 v = {lo, hi}; bf16x2_t b = __builtin_convertvector(v, bf16x2_t); return __builtin_bit_cast(unsigned, b); }
DI float bf_lo(unsigned w) { return __uint_as_float(w << 16); }
DI float bf_hi(unsigned w) { return __uint_as_float(w & 0xffff0000u); }
DI float wave_sum(float v) {
#pragma unroll
    for (int o = 1; o < 64; o <<= 1) v += __shfl_xor(v, o);
    return v;
}
DI float fast_rcp(float x) { return __builtin_amdgcn_rcpf(x); }
DI float fast_exp2(float x) { return __builtin_amdgcn_exp2f(x); }
DI float fast_log2(float x) { return __builtin_amdgcn_logf(x); }
DI float gelu_tanh(float x) { const float u = 0.7978845608028654f * (x + 0.044715f * x * x * x); return x * fast_rcp(1.f + fast_exp2(-2.f * LOG2E * u)); }
DI float silu(float x) { return x * fast_rcp(1.f + fast_exp2(-LOG2E * x)); }
#define LDS_WAIT() asm volatile("s_waitcnt lgkmcnt(0)" ::: "memory")
DI int opaque_tid(int wave_s) { unsigned m = ~0u; asm volatile("" : "+s"(m)); int l = (int)__builtin_amdgcn_mbcnt_hi(m, __builtin_amdgcn_mbcnt_lo(m, 0u)); asm volatile("" : "+v"(l)); asm volatile("" : "+s"(wave_s)); return (wave_s << 6) | l; }
DI int opaque_s(int v) { asm volatile("" : "+s"(v)); return v; }
template <class T> DI T* opaque_p(T* p) { asm volatile("" : "+s"(p)); return p; }

namespace pg8 {
constexpr int BM = 256, BK = 64, HALF = 128, HTB = HALF * BK * 2, STAGE_BYTES = 8 * HTB, NXCD = 8, WGM = 8;
__host__ __device__ __forceinline__ int lds_byte(int r, int c) { const int st = (r >> 4) * 2 + (c >> 5), rr = r & 15, cc = c & 31, ob = rr * 64 + cc * 2; return st * 1024 + (ob ^ (((ob >> 9) & 1) << 5)); }
__host__ __device__ __forceinline__ void stage_rc(int b, int& R, int& C) { const int st = b / 1024, sb = b % 1024, swz = sb ^ (((sb >> 9) & 1) << 5); R = (st >> 1) * 16 + swz / 64; C = (st & 1) * 32 + (swz % 64) / 2; }
__host__ __device__ __forceinline__ int perm32(int rho) { const int n = rho >> 4, i = rho & 15; return 8 * (i >> 2) + 4 * n + (i & 3); }

struct Unit { int pm, pn; };
struct Gemm { const bf16_t* A; int lda; const bf16_t* Bt; int ldb; int M, N, K; };

struct StaticOrder {
    int nM, nN, nwg, G, c;
    __host__ __device__ void init(int M, int N, int G_, int c_) { nM = M / BM; nN = N / BM; nwg = nM * nN; G = G_; c = c_; }
    __host__ __device__ bool next(int i, Unit& u) const {
        const long L = (long)i * G + c; if (L >= nwg) return false;
        int wgid = (int)L; { const int q = nwg / NXCD, r = nwg % NXCD, xcd = wgid % NXCD, off = wgid / NXCD; wgid = (xcd < r ? xcd * (q + 1) : r * (q + 1) + (xcd - r) * q) + off; }
        const int nig = WGM * nN, gid = wgid / nig, fm = gid * WGM, gsz = (nM - fm) < WGM ? (nM - fm) : WGM;
        u.pm = fm + ((wgid % nig) % gsz); u.pn = (wgid % nig) / gsz; return true;
    }
};

typedef f32x4 Acc[2][2][4][2];

DI float hrstd(const float* rsh, int r, int fq) {
    const char* rp = (const char*)rsh + (unsigned)((r * 32 + fq * 8) * 4);
    const f32x4 pa = *(const f32x4*)rp, pb = *(const f32x4*)(rp + 16);
    float s = ((pa[0] + pa[1]) + (pa[2] + pa[3])) + ((pb[0] + pb[1]) + (pb[2] + pb[3]));
    s += __shfl_xor(s, 16); s += __shfl_xor(s, 32);
    return __builtin_amdgcn_rsqf(s * (1.f / DM) + EPS);
}
DI float hrstd_t(const float* rsh, LAS const float* tab, int pm_base, int pm, int rl, int fq) {
    if ((unsigned)(pm - pm_base) < 8u) return tab[(pm - pm_base) * 256 + rl];
    return hrstd(rsh, pm * BM + rl, fq);
}
DI void rstd_tab_build(const float* rsh, int pm_base, LAS float* tab, int tid) {
#pragma unroll
    for (int k = 0; k < 4; ++k) {
        const int row = tid + 512 * k; const f32x4* p = (const f32x4*)(rsh + (size_t)(pm_base * BM + row) * 32);
        f32x4 a = p[0] + p[1]; f32x4 b = p[2] + p[3]; f32x4 c = p[4] + p[5]; f32x4 d = p[6] + p[7];
        a = (a + b) + (c + d);
        tab[row] = __builtin_amdgcn_rsqf(((a[0] + a[1]) + (a[2] + a[3])) * (1.f / DM) + EPS);
    }
    __syncthreads();
}
DI void rstd512_tab_build(const float* rsp, int pm_base, LAS float* tq, LAS float* tkv, int tid) {
#pragma unroll
    for (int k = 0; k < 4; ++k) {
        const int row = tid + 512 * k; const f32x4* p = (const f32x4*)(rsp + (size_t)(pm_base * BM + row) * 16);
        const f32x4 a = p[0] + p[1], b = p[2] + p[3];
        tq[row] = __builtin_amdgcn_rsqf(((a[0] + a[1]) + (a[2] + a[3])) * (1.f / 512.f) + EPS);
        tkv[row] = __builtin_amdgcn_rsqf(((b[0] + b[1]) + (b[2] + b[3])) * (1.f / 512.f) + EPS);
    }
    __syncthreads();
}
template <int ACT, int SCALE, bool ACC> struct EpiStore {
    static constexpr bool PERM = true;
    bf16_t* O; int ldc; const float* rs_in; float* rs_out; int acc_pn_lo; LAS const float* tab; int pm_base;
    DI void operator()(const Acc& acc, const Unit& u, int wr, int wc, int fr, int fq) const {
        const int row0 = u.pm * BM + wr * 64 + fr, col0 = u.pn * BM + wc * 32 + 8 * fq;
#pragma unroll
        for (int ai = 0; ai < 2; ++ai)
#pragma unroll
            for (int m = 0; m < 4; ++m) {
                const int r = row0 + ai * HALF + m * 16;
                float sc = 1.f; if (SCALE == 2) sc = hrstd_t(rs_in, tab, pm_base, u.pm, wr * 64 + fr + ai * HALF + m * 16, fq);
                if (SCALE == 1) {
                    if ((unsigned)(u.pm - pm_base) < 8u) sc = tab[(u.pm - pm_base) * 256 + wr * 64 + fr + ai * HALF + m * 16];
                    else { const f32x4 pa = *(const f32x4*)(rs_in + (size_t)r * 16), pb = *(const f32x4*)(rs_in + (size_t)r * 16 + 4);
                        sc = __builtin_amdgcn_rsqf((((pa[0] + pa[1]) + (pa[2] + pa[3])) + ((pb[0] + pb[1]) + (pb[2] + pb[3]))) * (1.f / 512.f) + EPS); } }
                float ss = 0.f;
                bf16_t* rowp = O + (size_t)r * ldc + col0;
#pragma unroll
                for (int bj = 0; bj < 2; ++bj) {
                    f32x4 v0 = acc[ai][bj][m][0], v1 = acc[ai][bj][m][1];
                    if (SCALE) { v0 = v0 * sc; v1 = v1 * sc; }
                    if (ACT == 1) {
#pragma unroll
                        for (int j = 0; j < 4; ++j) { v0[j] = gelu_tanh(v0[j]); v1[j] = gelu_tanh(v1[j]); }
                    }
                    if (ACC) ss += (v0[0] * v0[0] + v0[1] * v0[1]) + (v0[2] * v0[2] + v0[3] * v0[3]) + (v1[0] * v1[0] + v1[1] * v1[1]) + (v1[2] * v1[2] + v1[3] * v1[3]);
                    u32x4 w; w.x = pk2(v0[0], v0[1]); w.y = pk2(v0[2], v0[3]); w.z = pk2(v1[0], v1[1]); w.w = pk2(v1[2], v1[3]);
                    *(u32x4*)(rowp + bj * HALF) = w;
                }
                if (ACC) { if (u.pn >= acc_pn_lo) { ss += __shfl_xor(ss, 16); ss += __shfl_xor(ss, 32); if (fq == 0) rs_out[(size_t)r * 32 + (u.pn - acc_pn_lo) * 4 + wc] = ss; } }
            }
    }
};
template <int DQK_PITCH, int BJ_LO, int BJ_HI, class F>
DI void knorm_store(F v, bf16_t* Kn, const float* kgain, int head0, int head_bj_stride, const Unit& u, int wr, int wc, int fr, int fq, LAS float* xl) {
    const int rl0 = wr * 64 + fr;
#pragma unroll
    for (int ai = 0; ai < 2; ++ai)
#pragma unroll
        for (int m = 0; m < 4; ++m) { const int rl = ai * HALF + rl0 + m * 16;
#pragma unroll
            for (int bj = BJ_LO; bj < BJ_HI; ++bj) { const f32x4 v0 = v(ai, m, bj, 0), v1 = v(ai, m, bj, 1);
                float ss = (v0[0] * v0[0] + v0[1] * v0[1]) + (v0[2] * v0[2] + v0[3] * v0[3]) + (v1[0] * v1[0] + v1[1] * v1[1]) + (v1[2] * v1[2] + v1[3] * v1[3]);
                ss += __shfl_xor(ss, 16); ss += __shfl_xor(ss, 32); if (fq == 0) xl[(rl * 2 + bj) * 4 + wc] = ss; } }
    asm volatile("s_waitcnt lgkmcnt(0)" ::: "memory"); __builtin_amdgcn_s_barrier(); asm volatile("" ::: "memory");
    const f32x4 g0 = *(const f32x4*)(kgain + wc * 32 + 8 * fq), g1 = *(const f32x4*)(kgain + wc * 32 + 8 * fq + 4);
#pragma unroll
    for (int ai = 0; ai < 2; ++ai)
#pragma unroll
        for (int m = 0; m < 4; ++m) { const int rl = ai * HALF + rl0 + m * 16, row = u.pm * BM + rl, b = row >> 11, sq = row & (SEQ - 1);
#pragma unroll
            for (int bj = BJ_LO; bj < BJ_HI; ++bj) { const f32x4 pt = *(const LAS f32x4*)(xl + (rl * 2 + bj) * 4);
                const float r = __builtin_amdgcn_rsqf(((pt[0] + pt[1]) + (pt[2] + pt[3])) * (1.f / 128.f) + EPS);
                const f32x4 v0 = v(ai, m, bj, 0) * r * g0, v1 = v(ai, m, bj, 1) * r * g1;
                u32x4 w; w.x = pk2(v0[0], v0[1]); w.y = pk2(v0[2], v0[3]); w.z = pk2(v1[0], v1[1]); w.w = pk2(v1[2], v1[3]);
                *(u32x4*)(Kn + ((size_t)(b * 16 + head0 + bj * head_bj_stride) * SEQ + sq) * DQK_PITCH + wc * 32 + 8 * fq) = w; } }
}
template <bool FOX> struct EpiQKV {
    static constexpr bool PERM = true;
    bf16_t* O; bf16_t* Kn; const float* kgain; float* flog; const float* rsh; LAS float* xl; LAS const float* tab; int pm_base;
    DI void operator()(const Acc& acc, const Unit& u, int wr, int wc, int fr, int fq) const {
        const int row0 = u.pm * BM + wr * 64 + fr;
        float sc[2][4];
#pragma unroll
        for (int ai = 0; ai < 2; ++ai)
#pragma unroll
            for (int m = 0; m < 4; ++m) sc[ai][m] = hrstd_t(rsh, tab, pm_base, u.pm, wr * 64 + fr + ai * HALF + m * 16, fq);
        if (u.pn >= 8 && u.pn < 16) {
            knorm_store<128, 0, 2>([&](int ai, int m, int bj, int n) { return acc[ai][bj][m][n] * sc[ai][m]; }, Kn, kgain, (u.pn - 8) * 2, 1, u, wr, wc, fr, fq, xl);
        } else if (!FOX || u.pn < 24) {
            const int col0 = u.pn * BM + wc * 32 + 8 * fq;
#pragma unroll
            for (int ai = 0; ai < 2; ++ai)
#pragma unroll
                for (int m = 0; m < 4; ++m) {
                    bf16_t* rowp = O + (size_t)(row0 + ai * HALF + m * 16) * 6144 + col0;
#pragma unroll
                    for (int bj = 0; bj < 2; ++bj) {
                        const f32x4 v0 = acc[ai][bj][m][0] * sc[ai][m], v1 = acc[ai][bj][m][1] * sc[ai][m];
                        u32x4 w; w.x = pk2(v0[0], v0[1]); w.y = pk2(v0[2], v0[3]); w.z = pk2(v1[0], v1[1]); w.w = pk2(v1[2], v1[3]);
                        *(u32x4*)(rowp + bj * HALF) = w;
                    }
                }
        } else if (wc == 0 && fq < 2) {
#pragma unroll
            for (int ai = 0; ai < 2; ++ai)
#pragma unroll
                for (int m = 0; m < 4; ++m) {
                    float* rowp = flog + (size_t)(row0 + ai * HALF + m * 16) * 16 + 8 * fq;
                    *(f32x4*)(rowp) = acc[ai][0][m][0] * sc[ai][m]; *(f32x4*)(rowp + 4) = acc[ai][0][m][1] * sc[ai][m];
                }
        }
    }
};
struct EpiMlaKV {
    static constexpr bool PERM = true;
    bf16_t* KV; bf16_t* Kn; const float* kgain; const float* rs_in; LAS float* xl; LAS const float* tab; int pm_base;
    DI void operator()(const Acc& acc, const Unit& u, int wr, int wc, int fr, int fq) const {
        const int row0 = u.pm * BM + wr * 64 + fr;
        float sc[2][4];
#pragma unroll
        for (int ai = 0; ai < 2; ++ai)
#pragma unroll
            for (int m = 0; m < 4; ++m) { const int r = row0 + ai * HALF + m * 16;
                if ((unsigned)(u.pm - pm_base) < 8u) sc[ai][m] = tab[(u.pm - pm_base) * 256 + wr * 64 + fr + ai * HALF + m * 16];
                else { const f32x4 pa = *(const f32x4*)(rs_in + (size_t)r * 16), pb = *(const f32x4*)(rs_in + (size_t)r * 16 + 4);
                    sc[ai][m] = __builtin_amdgcn_rsqf((((pa[0] + pa[1]) + (pa[2] + pa[3])) + ((pb[0] + pb[1]) + (pb[2] + pb[3]))) * (1.f / 512.f) + EPS); } }
#pragma unroll
        for (int ai = 0; ai < 2; ++ai)
#pragma unroll
            for (int m = 0; m < 4; ++m) {
                const f32x4 v0 = acc[ai][1][m][0] * sc[ai][m], v1 = acc[ai][1][m][1] * sc[ai][m];
                u32x4 w; w.x = pk2(v0[0], v0[1]); w.y = pk2(v0[2], v0[3]); w.z = pk2(v1[0], v1[1]); w.w = pk2(v1[2], v1[3]);
                *(u32x4*)(KV + (size_t)(row0 + ai * HALF + m * 16) * 4096 + u.pn * BM + HALF + wc * 32 + 8 * fq) = w;
            }
        knorm_store<192, 0, 1>([&](int ai, int m, int bj, int n) { return acc[ai][bj][m][n] * sc[ai][m]; }, Kn, kgain, u.pn, 0, u, wr, wc, fr, fq, xl);
    }
};
struct EpiMlaIn {
    static constexpr bool PERM = true;
    bf16_t* O; float* rsp; float* krope; const float* rsh; LAS const float* tab; int pm_base;
    DI void operator()(const Acc& acc, const Unit& u, int wr, int wc, int fr, int fq) const {
        const int row0 = u.pm * BM + wr * 64 + fr;
        float sc[2][4];
#pragma unroll
        for (int ai = 0; ai < 2; ++ai)
#pragma unroll
            for (int m = 0; m < 4; ++m) sc[ai][m] = hrstd_t(rsh, tab, pm_base, u.pm, wr * 64 + fr + ai * HALF + m * 16, fq);
        if (u.pn < 4) {
            const int col0 = u.pn * BM + wc * 32 + 8 * fq;
#pragma unroll
            for (int ai = 0; ai < 2; ++ai)
#pragma unroll
                for (int m = 0; m < 4; ++m) {
                    const int r = row0 + ai * HALF + m * 16;
                    bf16_t* rowp = O + (size_t)r * 1024 + col0; float ss = 0.f;
#pragma unroll
                    for (int bj = 0; bj < 2; ++bj) {
                        const f32x4 v0 = acc[ai][bj][m][0] * sc[ai][m], v1 = acc[ai][bj][m][1] * sc[ai][m];
                        ss += (v0[0] * v0[0] + v0[1] * v0[1]) + (v0[2] * v0[2] + v0[3] * v0[3]) + (v1[0] * v1[0] + v1[1] * v1[1]) + (v1[2] * v1[2] + v1[3] * v1[3]);
                        u32x4 w; w.x = pk2(v0[0], v0[1]); w.y = pk2(v0[2], v0[3]); w.z = pk2(v1[0], v1[1]); w.w = pk2(v1[2], v1[3]);
                        *(u32x4*)(rowp + bj * HALF) = w;
                    }
                    ss += __shfl_xor(ss, 16); ss += __shfl_xor(ss, 32); if (fq == 0) rsp[(size_t)r * 16 + u.pn * 4 + wc] = ss;
                }
        } else if (wc < 2) {
#pragma unroll
            for (int ai = 0; ai < 2; ++ai)
#pragma unroll
                for (int m = 0; m < 4; ++m) {
                    float* rowp = krope + (size_t)(row0 + ai * HALF + m * 16) * 64 + wc * 32 + 8 * fq;
                    *(f32x4*)(rowp) = acc[ai][0][m][0] * sc[ai][m]; *(f32x4*)(rowp + 4) = acc[ai][0][m][1] * sc[ai][m];
                }
        }
    }
};
template <bool BASE_F32, bool OUT_F32> struct EpiResid {
    static constexpr bool PERM = true;
    const float* base; float* out; bf16_t* xb; float* rsh;
    DI void operator()(const Acc& acc, const Unit& u, int wr, int wc, int fr, int fq) const {
        const int row0 = u.pm * BM + wr * 64 + fr, col0 = u.pn * BM + wc * 32 + 8 * fq;
#pragma unroll
        for (int ai = 0; ai < 2; ++ai)
#pragma unroll
            for (int m = 0; m < 4; ++m) {
                const int r = row0 + ai * HALF + m * 16; const size_t off = (size_t)r * DM + col0; float ss = 0.f;
#pragma unroll
                for (int bj = 0; bj < 2; ++bj) {
                    f32x4 v0, v1;
                    if (BASE_F32) { v0 = *(const f32x4*)(base + off + bj * HALF); v1 = *(const f32x4*)(base + off + bj * HALF + 4); }
                    else { const u32x4 b = *(const u32x4*)(xb + off + bj * HALF); v0 = (f32x4){bf_lo(b.x), bf_hi(b.x), bf_lo(b.y), bf_hi(b.y)}; v1 = (f32x4){bf_lo(b.z), bf_hi(b.z), bf_lo(b.w), bf_hi(b.w)}; }
                    v0 = v0 + acc[ai][bj][m][0]; v1 = v1 + acc[ai][bj][m][1];
                    if (OUT_F32) { *(f32x4*)(out + off + bj * HALF) = v0; *(f32x4*)(out + off + bj * HALF + 4) = v1; }
                    else {
                        ss += (v0[0] * v0[0] + v0[1] * v0[1]) + (v0[2] * v0[2] + v0[3] * v0[3]) + (v1[0] * v1[0] + v1[1] * v1[1]) + (v1[2] * v1[2] + v1[3] * v1[3]);
                        u32x4 w; w.x = pk2(v0[0], v0[1]); w.y = pk2(v0[2], v0[3]); w.z = pk2(v1[0], v1[1]); w.w = pk2(v1[2], v1[3]);
                        *(u32x4*)(xb + off + bj * HALF) = w;
                    }
                }
                if (!OUT_F32) { ss += __shfl_xor(ss, 16); ss += __shfl_xor(ss, 32); if (fq == 0) rsh[(size_t)r * 32 + u.pn * 4 + wc] = ss; }
            }
    }
};

DI float dpp_ror1(float v) { return __builtin_bit_cast(float, __builtin_amdgcn_update_dpp(0, __builtin_bit_cast(int, v), 0x121, 0xf, 0xf, false)); }
DI float dpp_ror2(float v) { return __builtin_bit_cast(float, __builtin_amdgcn_update_dpp(0, __builtin_bit_cast(int, v), 0x122, 0xf, 0xf, false)); }
DI unsigned dpp_ror1u(unsigned v) { return (unsigned)__builtin_amdgcn_mov_dpp((int)v, 0x121, 0xf, 0xf, false); }
DI unsigned dpp_ror2u(unsigned v) { return (unsigned)__builtin_amdgcn_mov_dpp((int)v, 0x122, 0xf, 0xf, false); }
DI unsigned dpp_shr1u(unsigned old, unsigned v) { return (unsigned)__builtin_amdgcn_update_dpp((int)old, (int)v, 0x111, 0xf, 0xf, false); }
DI unsigned dpp_shr2u(unsigned old, unsigned v) { return (unsigned)__builtin_amdgcn_update_dpp((int)old, (int)v, 0x112, 0xf, 0xf, false); }
struct EpiUpConv {
    static constexpr bool PERM = true;
    bf16_t* act; const float* rsh; const float* cw; const float* cb; float* halo; LAS float* xl; LAS const float* tab; int pm_base;
    static DI f32x4 conv4(u32x2 cur, u32x2& p1, u32x2& p2, bool f1, bool f2, f32x4 w0, f32x4 w1, f32x4 w2, f32x4 bb) {
        u32x2 s1, s2; s1.x = dpp_shr1u(p1.x, cur.x); s1.y = dpp_shr1u(p1.y, cur.y); s2.x = dpp_shr2u(p2.x, cur.x); s2.y = dpp_shr2u(p2.y, cur.y);
        p1.x = dpp_ror1u(cur.x); p1.y = dpp_ror1u(cur.y); p2.x = dpp_ror2u(cur.x); p2.y = dpp_ror2u(cur.y);
        f32x4 y;
        y[0] = bb[0] + w0[0] * bf_lo(s2.x) + w1[0] * bf_lo(s1.x) + w2[0] * bf_lo(cur.x);
        y[1] = bb[1] + w0[1] * bf_hi(s2.x) + w1[1] * bf_hi(s1.x) + w2[1] * bf_hi(cur.x);
        y[2] = bb[2] + w0[2] * bf_lo(s2.y) + w1[2] * bf_lo(s1.y) + w2[2] * bf_lo(cur.y);
        y[3] = bb[3] + w0[3] * bf_hi(s2.y) + w1[3] * bf_hi(s1.y) + w2[3] * bf_hi(cur.y);
        return y;
    }
    DI void operator()(Acc& acc, const Unit& u, int wr, int wc, int fr, int fq) const {
        asm volatile("" : "+v"(fr), "+v"(fq));
        const int row0 = u.pm * BM + wr * 64 + fr, cl = wc * 32 + 8 * fq;
        f32x4 wg[2][4], wv[2][4];
#pragma unroll
        for (int n = 0; n < 2; ++n) {
            const int cg = u.pn * 128 + cl + 4 * n, cv = DFF + cg;
            const char* gp = (const char*)cw + (unsigned)(cg * 4); const char* vp = (const char*)cw + (unsigned)(cv * 4);
            wg[n][0] = *(const f32x4*)gp; wg[n][1] = *(const f32x4*)(gp + 8 * DFF); wg[n][2] = *(const f32x4*)(gp + 16 * DFF); wg[n][3] = *(const f32x4*)((const char*)cb + (unsigned)(cg * 4));
            wv[n][0] = *(const f32x4*)vp; wv[n][1] = *(const f32x4*)(vp + 8 * DFF); wv[n][2] = *(const f32x4*)(vp + 16 * DFF); wv[n][3] = *(const f32x4*)((const char*)cb + (unsigned)(cv * 4));
        }
        u32x2 pk[2][2][4][2];
        float scv[2][4];
#pragma unroll
        for (int ai = 0; ai < 2; ++ai)
#pragma unroll
            for (int m = 0; m < 4; ++m) scv[ai][m] = hrstd_t(rsh, tab, pm_base, u.pm, wr * 64 + fr + ai * HALF + m * 16, fq);
#pragma unroll
        for (int ai = 0; ai < 2; ++ai)
#pragma unroll
            for (int m = 0; m < 4; ++m) { const float sc = scv[ai][m];
#pragma unroll
                for (int bj = 0; bj < 2; ++bj) {
                    const f32x4 v0 = acc[ai][bj][m][0] * sc, v1 = acc[ai][bj][m][1] * sc;
                    if (m == 3 && fr >= 14) { LAS float* d = xl + ((((ai * 2 + wr) * 2 + bj) * 2 + (fr - 14)) * 128) + cl; *(LAS f32x4*)d = v0; *(LAS f32x4*)(d + 4) = v1; }
                    if (ai == 0 && m == 0 && wr == 0 && fr < 2) { float* d = (float*)((char*)halo + (unsigned)((((u.pm * 2 + bj) * 4 + fr) * DFF + u.pn * 128 + cl) * 4)); *(f32x4*)d = v0; *(f32x4*)(d + 4) = v1; }
                    if (ai == 1 && m == 3 && wr == 1 && fr >= 14) { float* d = (float*)((char*)halo + (unsigned)((((u.pm * 2 + bj) * 4 + 2 + (fr - 14)) * DFF + u.pn * 128 + cl) * 4)); *(f32x4*)d = v0; *(f32x4*)(d + 4) = v1; }
                    pk[ai][bj][m][0].x = pk2(v0[0], v0[1]); pk[ai][bj][m][0].y = pk2(v0[2], v0[3]); pk[ai][bj][m][1].x = pk2(v1[0], v1[1]); pk[ai][bj][m][1].y = pk2(v1[2], v1[3]);
                }
                __builtin_amdgcn_sched_barrier(0); }
        asm volatile("s_waitcnt lgkmcnt(0)" ::: "memory"); __builtin_amdgcn_s_barrier(); asm volatile("" ::: "memory");
        const bool f1 = fr >= 1, f2 = fr >= 2;
#pragma unroll
        for (int n = 0; n < 2; ++n) {
            const int cg = u.pn * 128 + cl + 4 * n;
            const f32x4 g0 = wg[n][0], g1 = wg[n][1], g2 = wg[n][2], gb = wg[n][3], v0 = wv[n][0], v1 = wv[n][1], v2 = wv[n][2], vbb = wv[n][3];
#pragma unroll
            for (int ai = 0; ai < 2; ++ai) {
                const int sg = wr == 1 ? ai * 2 : 1;
                f32x4 bg_ = *(const LAS f32x4*)(xl + (((sg * 2 + 0) * 2 + (fr & 1)) * 128) + cl + 4 * n), bv_ = *(const LAS f32x4*)(xl + (((sg * 2 + 1) * 2 + (fr & 1)) * 128) + cl + 4 * n);
                if ((ai | wr) == 0) { bg_ = (f32x4){0.f, 0.f, 0.f, 0.f}; bv_ = bg_; }
                u32x2 tg, tv; tg.x = pk2(bg_[0], bg_[1]); tg.y = pk2(bg_[2], bg_[3]); tv.x = pk2(bv_[0], bv_[1]); tv.y = pk2(bv_[2], bv_[3]);
                u32x2 pg1, pg2, pv1, pv2; pg1.x = dpp_ror1u(tg.x); pg1.y = dpp_ror1u(tg.y); pg2.x = dpp_ror2u(tg.x); pg2.y = dpp_ror2u(tg.y);
                pv1.x = dpp_ror1u(tv.x); pv1.y = dpp_ror1u(tv.y); pv2.x = dpp_ror2u(tv.x); pv2.y = dpp_ror2u(tv.y);
#pragma unroll
                for (int m = 0; m < 4; ++m) {
                    const f32x4 yv = conv4(pk[ai][1][m][n], pv1, pv2, f1, f2, v0, v1, v2, vbb);
                    const f32x4 yg = conv4(pk[ai][0][m][n], pg1, pg2, f1, f2, g0, g1, g2, gb);
                    u32x2 w; w.x = pk2(silu(yg[0]) * yv[0], silu(yg[1]) * yv[1]); w.y = pk2(silu(yg[2]) * yv[2], silu(yg[3]) * yv[3]);
                    *(u32x2*)((char*)act + (unsigned)(((row0 + ai * HALF + m * 16) * DFF + cg) * 2)) = w;
                    __builtin_amdgcn_sched_barrier(0);
                }
            }
        }
    }
};

template <class Epi, class Sched, bool ALIGN_EPI = true, bool SP2 = true>
DI void gemm_phase(LAS unsigned char* lds, const Gemm g, const Sched& S, const Epi& E, int wave_s) {
    const int tid = opaque_tid(wave_s), wid = __builtin_amdgcn_readfirstlane(tid >> 6), lane = tid & 63, wr = wid >> 2, wc = wid & 3, fr = lane & 15, fq = lane >> 4;
    const int K = g.K, nt = K / BK;
    unsigned voffA[2], voffB[2];
#pragma unroll
    for (int i = 0; i < 2; ++i) { int R, C; stage_rc(tid * 16 + i * 8192, R, C); const int Rb = Epi::PERM ? ((R & ~31) + perm32(R & 31)) : R;
        voffA[i] = (unsigned)(R * g.lda + C) * 2u; voffB[i] = (unsigned)(Rb * g.ldb + C) * 2u; }
    const size_t kstep = (size_t)(BK * 2);
    const size_t hstepA = (size_t)HALF * g.lda * 2, hstepB = (size_t)HALF * g.ldb * 2;
    const size_t tstepA = 2 * hstepA, tstepB = 2 * hstepB;
    const unsigned ldsw = (unsigned)wid * 1024u;
    const int aoff = lds_byte(wr * 64 + fr, fq * 8), boff = lds_byte(wc * 32 + fr, fq * 8);
#define PG8_SA(b, h) (((b) * 2 + (h)) * HTB)
#define PG8_SB(b, h) ((4 + (b) * 2 + (h)) * HTB)
#define PG8_STAGE(bufoff, gbase, voff) do { _Pragma("unroll") for (int _i = 0; _i < 2; ++_i) \
        __builtin_amdgcn_global_load_lds((const unsigned*)((const char*)(gbase) + (voff)[_i]), (LAS unsigned*)(lds + (bufoff) + ldsw + _i * 8192), 16, 0, 0); } while (0)
#define PG8_LDA(dst, b, h) do { _Pragma("unroll") for (int m = 0; m < 4; ++m) _Pragma("unroll") for (int k = 0; k < 2; ++k) dst[m][k] = *(const LAS bf16x8*)(lds + PG8_SA(b, h) + aoff + m * 2048 + k * 1024); } while (0)
#define PG8_LDB(dst, b, h) do { _Pragma("unroll") for (int n = 0; n < 2; ++n) _Pragma("unroll") for (int k = 0; k < 2; ++k) dst[n][k] = *(const LAS bf16x8*)(lds + PG8_SB(b, h) + boff + n * 2048 + k * 1024); } while (0)
#define PG8_MMA(ai, bj, At, Bt) do { __builtin_amdgcn_s_setprio(1); _Pragma("unroll") for (int m = 0; m < 4; ++m) _Pragma("unroll") for (int n = 0; n < 2; ++n) _Pragma("unroll") for (int k = 0; k < 2; ++k) \
        acc[ai][bj][m][n] = __builtin_amdgcn_mfma_f32_16x16x32_bf16(Bt[n][k], At[m][k], acc[ai][bj][m][n], 0, 0, 0); __builtin_amdgcn_s_setprio(0); } while (0)
#define PG8_WAIT_V(n) asm volatile("s_waitcnt vmcnt(" #n ")" ::: "memory")
#define PG8_WAIT_L(n) asm volatile("s_waitcnt lgkmcnt(" #n ")" ::: "memory")
#define PG8_BAR __builtin_amdgcn_s_barrier()
#define PG8_SCHED __builtin_amdgcn_sched_barrier(0)
    Unit cur, nxt; int ui = 0;
    if (!S.next(0, cur)) return;
    f32x4 acc[2][2][4][2];
#pragma unroll
    for (int a = 0; a < 2; ++a)
#pragma unroll
        for (int b = 0; b < 2; ++b)
#pragma unroll
            for (int m = 0; m < 4; ++m)
#pragma unroll
                for (int n = 0; n < 2; ++n) acc[a][b][m][n] = (f32x4){0.f, 0.f, 0.f, 0.f};
    bf16x8 At[4][2], B0[2][2], B1[2][2];
    const char* cA = (const char*)g.A + (size_t)cur.pm * tstepA; const char* cB = (const char*)g.Bt + (size_t)cur.pn * tstepB;
    {
        PG8_STAGE(PG8_SB(0, 0), cB, voffB); PG8_STAGE(PG8_SB(0, 1), cB + hstepB, voffB); PG8_STAGE(PG8_SA(0, 0), cA, voffA); PG8_STAGE(PG8_SA(0, 1), cA + hstepA, voffA);
        if (wr == 1) PG8_BAR;
        PG8_WAIT_V(2); PG8_BAR;
        PG8_STAGE(PG8_SB(1, 0), cB + kstep, voffB); PG8_STAGE(PG8_SA(1, 0), cA + kstep, voffA); PG8_STAGE(PG8_SB(1, 1), cB + hstepB + kstep, voffB);
        PG8_WAIT_V(6); PG8_BAR;
    }
    for (;;) {
        const bool has_next = S.next(ui + 1, nxt);
        const char* nA = has_next ? (const char*)g.A + (size_t)nxt.pm * tstepA : cA; const char* nB = has_next ? (const char*)g.Bt + (size_t)nxt.pn * tstepB : cB;
        for (int t = 0; t < nt; t += 2) {
            const bool last = (t == nt - 2);
            const char* a1 = cA + (size_t)(t + 1) * kstep;
            const char* a2 = last ? nA : cA + (size_t)(t + 2) * kstep; const char* b2 = last ? nB : cB + (size_t)(t + 2) * kstep;
            const char* a3 = a2 + kstep; const char* b3 = b2 + kstep;
            PG8_LDB(B0, 0, 0); PG8_LDB(B1, 0, 1); PG8_SCHED; PG8_LDA(At, 0, 0); PG8_STAGE(PG8_SA(1, 1), a1 + hstepA, voffA);
            PG8_WAIT_V(8); PG8_WAIT_L(0); PG8_BAR; PG8_MMA(0, 0, At, B0); PG8_MMA(0, 1, At, B1); PG8_BAR; PG8_SCHED;
            PG8_LDA(At, 0, 1); PG8_STAGE(PG8_SB(0, 0), b2, voffB); PG8_STAGE(PG8_SB(0, 1), b2 + hstepB, voffB); PG8_STAGE(PG8_SA(0, 0), a2, voffA);
            PG8_WAIT_V(8); PG8_WAIT_L(0); PG8_BAR; PG8_MMA(1, 0, At, B0); PG8_MMA(1, 1, At, B1); PG8_BAR; PG8_SCHED;
            PG8_LDB(B0, 1, 0); PG8_LDB(B1, 1, 1); PG8_SCHED; PG8_LDA(At, 1, 0); PG8_STAGE(PG8_SA(0, 1), a2 + hstepA, voffA);
            PG8_WAIT_V(8); PG8_WAIT_L(0); PG8_BAR; PG8_MMA(0, 0, At, B0); PG8_MMA(0, 1, At, B1); PG8_BAR; PG8_SCHED;
            PG8_LDA(At, 1, 1); PG8_STAGE(PG8_SB(1, 0), b3, voffB); PG8_STAGE(PG8_SB(1, 1), b3 + hstepB, voffB); PG8_STAGE(PG8_SA(1, 0), a3, voffA);
            PG8_WAIT_V(8); PG8_WAIT_L(0); PG8_BAR; PG8_MMA(1, 0, At, B0); PG8_MMA(1, 1, At, B1); PG8_BAR; PG8_SCHED;
        }
        if constexpr (ALIGN_EPI) { if (wr == 0) PG8_BAR; }
        E(acc, cur, wr, wc, fr, fq);
        if (!has_next) break;
#pragma unroll
        for (int a = 0; a < 2; ++a)
#pragma unroll
            for (int b = 0; b < 2; ++b)
#pragma unroll
                for (int m = 0; m < 4; ++m)
#pragma unroll
                    for (int n = 0; n < 2; ++n) acc[a][b][m][n] = (f32x4){0.f, 0.f, 0.f, 0.f};
        cur = nxt; cA = nA; cB = nB; ++ui;
        if constexpr (ALIGN_EPI) { if (wr == 1) PG8_BAR; }
    }
    PG8_WAIT_V(0);
    if constexpr (!ALIGN_EPI) { if (wr == 0) PG8_BAR; }
    PG8_BAR;
#undef PG8_SA
#undef PG8_SB
#undef PG8_STAGE
#undef PG8_LDA
#undef PG8_LDB
#undef PG8_MMA
#undef PG8_WAIT_V
#undef PG8_WAIT_L
#undef PG8_BAR
#undef PG8_SCHED
}
}

constexpr size_t MiB = 1u << 20;
constexpr size_t WS_RSH = 390 * MiB, WS_RSP = 12 * MiB, WS_RSSGU = 13 * MiB;
constexpr size_t WS_FLOG = 1 * MiB, WS_CUM = 2 * MiB, WS_KROPE = 4 * MiB, WS_RCS = 8 * MiB, WS_RSN = 10 * MiB;
constexpr size_t WS_W = 16 * MiB;
constexpr size_t W_FOX_IN = WS_W, W_FOX_OUT = W_FOX_IN + 25 * MiB, W_MLA_IN = W_FOX_OUT + 8 * MiB, W_MLA_QB = W_MLA_IN + 5 * MiB, W_MLA_KVB = W_MLA_QB + 3 * MiB,
                 W_MLA_OUT = W_MLA_KVB + 4 * MiB, W_SB_IN = W_MLA_OUT + 8 * MiB, W_SB_OUT = W_SB_IN + 24 * MiB, W_SGU_IN = W_SB_OUT + 8 * MiB, W_SGU_OUT = W_SGU_IN + 16 * MiB,
                 W_UP = W_SGU_OUT + 8 * MiB, W_DOWN = W_UP + 4 * 44 * MiB, W_END = W_DOWN + 4 * 22 * MiB;
constexpr size_t WS_XB = 400 * MiB, WS_BIG = 464 * MiB, WS_ACT = 816 * MiB, WS_HALO = 992 * MiB, WS_END = 1004 * MiB;
static_assert(W_END <= WS_XB, "weights fit");

DI void convert_matrix(const float* __restrict__ W, const float* __restrict__ gain, bf16_t* __restrict__ WT, int K, int N, int Npad, LAS float* scrf, int gw, int NGW, int lane, bool perm_up = false) {
    LAS unsigned* scr = (LAS unsigned*)scrf;
    const int nblk = Npad / 64, nitems = (K / 64) * nblk;
    const int c = lane & 15, g = lane >> 4;
#define CM_LOAD(it_, dst) do { const int kb_ = (it_) / nblk, nb_ = (it_) % nblk; const int n_ = 64 * nb_ + 4 * c; const bool ok_ = n_ < N; \
        const float* wp_ = W + (size_t)(64 * kb_ + 2 * g) * N + n_; \
        _Pragma("unroll") for (int j = 0; j < 8; ++j) _Pragma("unroll") for (int e = 0; e < 2; ++e) \
            dst[2 * j + e] = ok_ ? __builtin_nontemporal_load((const f32x4*)(wp_ + (size_t)(8 * j + e) * N)) : (f32x4){0.f, 0.f, 0.f, 0.f}; } while (0)
    f32x4 v[16], vn[16];
    int it = gw;
    if (it < nitems) CM_LOAD(it, v);
    while (it < nitems) {
        const int nxt = it + NGW;
        if (nxt < nitems) CM_LOAD(nxt, vn);
        const int kb = it / nblk, nb = it % nblk, k0 = 64 * kb, n0 = 64 * nb;
        const int nd0 = !perm_up ? n0 : (n0 < DFF ? (n0 >> 7) * 256 + (n0 & 127) : ((n0 - DFF) >> 7) * 256 + 128 + ((n0 - DFF) & 127));
        if (gain) {
#pragma unroll
            for (int j = 0; j < 8; ++j) { const f32x2 gg = *(const f32x2*)(gain + k0 + 8 * j + 2 * g); v[2 * j] = v[2 * j] * gg.x; v[2 * j + 1] = v[2 * j + 1] * gg.y; }
        }
#pragma unroll
        for (int j = 0; j < 8; ++j)
#pragma unroll
            for (int q = 0; q < 4; ++q) scr[(4 * c + q) * 33 + 4 * j + g] = pk2(v[2 * j][q], v[2 * j + 1][q]);
        LDS_WAIT();
#pragma unroll
        for (int i = 0; i < 8; ++i) {
            const int nl = (lane >> 3) + 8 * i, q = lane & 7; const LAS unsigned* sp = scr + nl * 33 + 4 * q;
            u32x4 o; o.x = sp[0]; o.y = sp[1]; o.z = sp[2]; o.w = sp[3];
            *(u32x4*)(WT + (size_t)(nd0 + nl) * K + k0 + 8 * q) = o;
        }
        LDS_WAIT();
#pragma unroll
        for (int j = 0; j < 16; ++j) v[j] = vn[j];
        it = nxt;
    }
#undef CM_LOAD
}

DI void norm_phase(const float* __restrict__ h, bf16_t* __restrict__ xb, float* __restrict__ rsh, int vcu, int G, int wave_s) {
    const int tid = opaque_tid(wave_s), lane = tid & 63, gw = vcu * 8 + (tid >> 6), NGW = G * 8;
    for (int r = gw; r < M_TOK; r += NGW) {
        const f32x4* xr = (const f32x4*)(h + (size_t)r * DM) + lane;
        f32x4 v[8]; float s = 0.f;
#pragma unroll
        for (int j = 0; j < 8; ++j) { v[j] = xr[64 * j]; s += (v[j].x * v[j].x + v[j].y * v[j].y) + (v[j].z * v[j].z + v[j].w * v[j].w); }
        s = wave_sum(s);
        if (lane < 32) rsh[(size_t)r * 32 + lane] = lane == 0 ? s : 0.f;
        u32x2* o = (u32x2*)(xb + (size_t)r * DM) + lane;
#pragma unroll
        for (int j = 0; j < 8; ++j) { u32x2 w; w.x = pk2(v[j].x, v[j].y); w.y = pk2(v[j].z, v[j].w); o[64 * j] = w; }
    }
}

DI void unpack8(const u32x4 w, float* f) { f[0] = bf_lo(w.x); f[1] = bf_hi(w.x); f[2] = bf_lo(w.y); f[3] = bf_hi(w.y); f[4] = bf_lo(w.z); f[5] = bf_hi(w.z); f[6] = bf_lo(w.w); f[7] = bf_hi(w.w); }
template <int MODE>
DI void kvprep_phase(LAS unsigned char* lds, const bf16_t* __restrict__ src, bf16_t* __restrict__ Kn, bf16_t* __restrict__ Vt, const float* __restrict__ kgain,
                     const float* __restrict__ flog, const float* __restrict__ bfp, float* __restrict__ cum, const float* __restrict__ krope, const float* __restrict__ rcs, const float* __restrict__ rsn,
                     int vcu, int G, int wave_s) {
    constexpr int DQK = MODE == 1 ? 192 : 128, LDS_ = MODE == 1 ? 4096 : 6144;
    const int tid = opaque_tid(wave_s), lane = tid & 63, wid = tid >> 6;
    if (MODE == 0) {
        const int gw = vcu * 8 + wid, NGW = G * 8;
        for (int q = gw; q < 128; q += NGW) {
            const int b = q >> 4, h = q & 15; const float bh_ = bfp[h];
            const float* fl = flog + (size_t)(b * SEQ + 32 * lane) * 16 + h;
            float lf[32]; float tot = 0.f;
#pragma unroll
            for (int j = 0; j < 32; ++j) { const float x = fl[j * 16] + bh_; lf[j] = -(fmaxf(-x, 0.f) + 0.6931471805599453f * fast_log2(1.f + fast_exp2(-LOG2E * fabsf(x)))); tot += lf[j]; }
            float incl = tot;
#pragma unroll
            for (int o = 1; o < 64; o <<= 1) { const float y = __shfl_up(incl, o); if (lane >= o) incl += y; }
            float run = incl - tot;
            float* co = cum + (size_t)q * SEQ + 32 * lane;
#pragma unroll
            for (int j = 0; j < 32; j += 4) { f32x4 o4; run += lf[j]; o4[0] = run; run += lf[j + 1]; o4[1] = run; run += lf[j + 2]; o4[2] = run; run += lf[j + 3]; o4[3] = run; *(f32x4*)(co + j) = o4; }
        }
    }
    if (MODE == 1) {
        constexpr int NIT = M_TOK * 16 * 4;
        const int gt = vcu * 512 + tid, GT = G * 512;
        for (int i = gt; i < NIT; i += GT) {
            const int cc = i & 3, h = (i >> 2) & 15, row = i >> 6;
            const float* kr = krope + (size_t)row * 64 + 8 * cc;
            const f32x4 a0 = *(const f32x4*)kr, a1 = *(const f32x4*)(kr + 4), b0 = *(const f32x4*)(kr + 32), b1 = *(const f32x4*)(kr + 36);
            float x1[8] = {a0[0], a0[1], a0[2], a0[3], a1[0], a1[1], a1[2], a1[3]}, x2[8] = {b0[0], b0[1], b0[2], b0[3], b1[0], b1[1], b1[2], b1[3]};
            float s2 = 0.f;
#pragma unroll
            for (int j = 0; j < 8; ++j) s2 += x1[j] * x1[j] + x2[j] * x2[j];
            s2 += __shfl_xor(s2, 1); s2 += __shfl_xor(s2, 2);
            const float rs = __builtin_amdgcn_rsqf(s2 * (1.f / 64.f) + EPS);
            float r1[8], r2[8];
            const f32x4 c0 = *(const f32x4*)(rcs + (size_t)row * 32 + 8 * cc), c1 = *(const f32x4*)(rcs + (size_t)row * 32 + 8 * cc + 4), n0 = *(const f32x4*)(rsn + (size_t)row * 32 + 8 * cc), n1 = *(const f32x4*)(rsn + (size_t)row * 32 + 8 * cc + 4);
#pragma unroll
            for (int j = 0; j < 8; ++j) {
                const int ii = 8 * cc + j;
                const float cs = j < 4 ? c0[j & 3] : c1[j & 3], sn = j < 4 ? n0[j & 3] : n1[j & 3];
                const float y1 = x1[j] * rs * kgain[128 + ii], y2 = x2[j] * rs * kgain[160 + ii];
                r1[j] = y1 * cs - y2 * sn; r2[j] = y1 * sn + y2 * cs;
            }
            const int b = row >> 11, sq = row & (SEQ - 1);
            bf16_t* ro = Kn + ((size_t)(b * 16 + h) * SEQ + sq) * DQK + 128 + 8 * cc;
            u32x4 w1, w2; w1.x = pk2(r1[0], r1[1]); w1.y = pk2(r1[2], r1[3]); w1.z = pk2(r1[4], r1[5]); w1.w = pk2(r1[6], r1[7]);
            w2.x = pk2(r2[0], r2[1]); w2.y = pk2(r2[2], r2[3]); w2.z = pk2(r2[4], r2[5]); w2.w = pk2(r2[6], r2[7]);
            *(u32x4*)ro = w1; *(u32x4*)(ro + 32) = w2;
        }
    }
}

#define MFMA32(a, b, c) __builtin_amdgcn_mfma_f32_32x32x16_bf16((a), (b), (c), 0, 0, 0)
template <int MODE>
DI void attn_phase(LAS unsigned char* lds, const bf16_t* __restrict__ Q, int ldq, int qhs, const bf16_t* __restrict__ Kn, const bf16_t* __restrict__ Vsrc, int ldv, int vhs,
                   const float* __restrict__ cum, const float* qgain, const float* __restrict__ rcs, const float* __restrict__ rsn, bf16_t* __restrict__ O, int vcu, int G, int wave_s) {
    constexpr int DQK = MODE == 1 ? 192 : 128, NST = DQK / 16, KP = DQK * 2 + 16, KBUF = 64 * KP, VP = 272, VBUF = 64 * VP, KCH = DQK / 8, KPT = 64 * KCH / 512;
    constexpr int OFF_V = 2 * KBUF, OFF_C = OFF_V + 3 * VBUF;
    const int tid = opaque_tid(wave_s), lane = tid & 63, w = __builtin_amdgcn_readfirstlane(tid >> 6), r32 = lane & 31, hi = lane >> 5;
    const float CS = (MODE == 1 ? 0.07216878364870322f : 0.08838834764831845f) * LOG2E;
    float fox_thr = 0.f;
    if constexpr (MODE == 0) {
        float gq = fmaxf(fabsf(qgain[lane]), fabsf(qgain[lane + 64])), gk = fmaxf(fabsf(rcs[lane]), fabsf(rcs[lane + 64]));
#pragma unroll
        for (int o = 1; o < 64; o <<= 1) { gq = fmaxf(gq, __shfl_xor(gq, o)); gk = fmaxf(gk, __shfl_xor(gk, o)); }
        fox_thr = 2.02f * (128.f * CS * gq * gk) + 160.f;
    }
    const int pim = (r32 & 0x13) | ((r32 & 4) << 1) | ((r32 & 8) >> 1);
    const unsigned kfo = pim * KP + hi * 16;
    const unsigned vfo = (unsigned)((8 * hi + ((lane & 15) >> 2)) * VP + ((lane >> 4) & 1) * 32 + (lane & 3) * 8);
    for (int g = vcu; g < 512; g += G) {
        const int bh = g >> 2, sub = g & 3, b = bh >> 4, h = bh & 15;
        const bf16_t* Kbh = Kn + (size_t)bh * SEQ * DQK; const bf16_t* Vbh = Vsrc + (size_t)b * SEQ * ldv + h * vhs; const float* cbh = cum + (size_t)bh * SEQ;
        for (int k4 = 0; k4 < 2; ++k4) {
            const int qb = (k4 == 0) ? 7 - sub : sub;
            const int q0 = qb * 256, NT = 4 * (qb + 1);
            int toff = 0;
            if constexpr (MODE == 0) {
                const float cq0 = cbh[q0];
                const bool far_ = lane < NT && (cbh[64 * (lane < NT ? lane : 0) + 63] - cq0) * LOG2E >= fox_thr;
                toff = (int)__popcll(__ballot(far_)); if (toff > NT - 1) toff = NT - 1;
                toff = __builtin_amdgcn_readfirstlane(toff);
            }
            const int NTe = NT - toff;
            const int qmin = q0 + 32 * w, qmax = qmin + 31, qg = qmin + r32;
            bf16x8 qf[NST];
            {
                const float* qgl = qgain; asm volatile("" : "+s"(qgl));
                int r32q = r32, hiq = hi; asm volatile("" : "+v"(r32q), "+v"(hiq));
                const bf16_t* qrow = (Q + (size_t)(b * SEQ + qmin) * ldq + h * qhs) + (unsigned)(r32q * ldq + 8 * hiq);
                u32x4 raw[NST];
#pragma unroll
                for (int st = 0; st < NST; ++st) raw[st] = *(const u32x4*)(qrow + 16 * st);
                float ssn = 0.f;
#pragma unroll
                for (int st = 0; st < 8; ++st) { float f[8]; unpack8(raw[st], f);
#pragma unroll
                    for (int j = 0; j < 8; ++j) ssn += f[j] * f[j]; }
                ssn += __shfl_xor(ssn, 32);
                const float rn = CS / sqrtf(ssn * (1.f / 128.f) + EPS);
#pragma unroll
                for (int st = 0; st < 8; ++st) { float f[8]; unpack8(raw[st], f);
                    const f32x4 g0 = *(const f32x4*)(qgl + 16 * st + 8 * hi), g1 = *(const f32x4*)(qgl + 16 * st + 8 * hi + 4);
                    u32x4 o; o.x = pk2(f[0] * rn * g0[0], f[1] * rn * g0[1]); o.y = pk2(f[2] * rn * g0[2], f[3] * rn * g0[3]);
                    o.z = pk2(f[4] * rn * g1[0], f[5] * rn * g1[1]); o.w = pk2(f[6] * rn * g1[2], f[7] * rn * g1[3]);
                    qf[st] = __builtin_bit_cast(bf16x8, o); }
                if constexpr (MODE == 1) {
                    float ssr = 0.f;
#pragma unroll
                    for (int st = 8; st < 12; ++st) { float f[8]; unpack8(raw[st], f);
#pragma unroll
                        for (int j = 0; j < 8; ++j) ssr += f[j] * f[j]; }
                    ssr += __shfl_xor(ssr, 32);
                    const float rr = 1.0f / sqrtf(ssr * (1.f / 64.f) + EPS);
                    const float* tc = (rcs + (size_t)(b * SEQ + qmin) * 32) + (unsigned)(r32q * 32 + 8 * hiq); const float* tn = (rsn + (size_t)(b * SEQ + qmin) * 32) + (unsigned)(r32q * 32 + 8 * hiq);
#pragma unroll
                    for (int a = 0; a < 2; ++a) {
                        float f1[8], f2[8], o1[8], o2[8]; unpack8(raw[8 + a], f1); unpack8(raw[10 + a], f2);
                        const f32x4 c0 = *(const f32x4*)(tc + 16 * a), c1 = *(const f32x4*)(tc + 16 * a + 4), n0 = *(const f32x4*)(tn + 16 * a), n1 = *(const f32x4*)(tn + 16 * a + 4);
#pragma unroll
                        for (int j = 0; j < 8; ++j) {
                            const int i = 16 * a + 8 * hi + j;
                            const float cs = j < 4 ? c0[j & 3] : c1[j & 3], sn = j < 4 ? n0[j & 3] : n1[j & 3];
                            const float y1 = f1[j] * rr * qgl[128 + i], y2 = f2[j] * rr * qgl[160 + i];
                            o1[j] = (y1 * cs - y2 * sn) * CS; o2[j] = (y1 * sn + y2 * cs) * CS;
                        }
                        u32x4 w1, w2; w1.x = pk2(o1[0], o1[1]); w1.y = pk2(o1[2], o1[3]); w1.z = pk2(o1[4], o1[5]); w1.w = pk2(o1[6], o1[7]);
                        w2.x = pk2(o2[0], o2[1]); w2.y = pk2(o2[2], o2[3]); w2.z = pk2(o2[4], o2[5]); w2.w = pk2(o2[6], o2[7]);
                        qf[8 + a] = __builtin_bit_cast(bf16x8, w1); qf[10 + a] = __builtin_bit_cast(bf16x8, w2);
                    }
                }
            }
            float m_run = -INFINITY, l_run = 0.f, carry = 1.f;
            f32x16 o[4];
#pragma unroll
            for (int d = 0; d < 4; ++d)
#pragma unroll
                for (int i = 0; i < 16; ++i) o[d][i] = 0.f;
            u32x4 kreg[KPT], vreg[2]; float creg = 0.f;
            int tidu = tid; asm volatile("" : "+v"(tidu));
            const unsigned kgo = (unsigned)(tidu * KPT * 16), vgo = (unsigned)(((tidu >> 3) * ldv + (tidu & 7) * 16) * 2);
            const unsigned klo = (unsigned)(((tidu * KPT) / KCH) * KP + ((tidu * KPT) % KCH) * 16), vlo = (unsigned)((tidu >> 3) * VP + (tidu & 7) * 32);
#define ATT_LOAD(t_) do { const int s0_ = (t_) * 64; const char* kg_ = (const char*)(Kbh + (size_t)s0_ * DQK) + kgo; const char* vg_ = (const char*)(Vbh + (size_t)s0_ * ldv) + vgo; \
        _Pragma("unroll") for (int i_ = 0; i_ < KPT; ++i_) kreg[i_] = *(const u32x4*)(kg_ + i_ * 16); \
        _Pragma("unroll") for (int i_ = 0; i_ < 2; ++i_) vreg[i_] = *(const u32x4*)(vg_ + i_ * 16); \
        if (MODE == 0) { if (tid < 64) creg = cbh[s0_ + tid] * LOG2E; } } while (0)
#define ATT_STORE(buf_, vbuf_) do { LAS unsigned char* kb_ = lds + (buf_) * KBUF + klo; \
        _Pragma("unroll") for (int i_ = 0; i_ < KPT; ++i_) *(LAS u32x4*)(kb_ + i_ * 16) = kreg[i_]; \
        LAS unsigned char* vb_ = lds + OFF_V + (vbuf_) * VBUF + vlo; \
        _Pragma("unroll") for (int i_ = 0; i_ < 2; ++i_) *(LAS u32x4*)(vb_ + i_ * 16) = vreg[i_]; \
        if (MODE == 0) { if (tid < 64) ((LAS float*)(lds + OFF_C))[(buf_) * 64 + tid] = creg; } } while (0)
#define ATT_PV(vbi_) do { LAS const unsigned char* vb = lds + OFF_V + (vbi_) * VBUF + vfo; \
        _Pragma("unroll") for (int d = 0; d < 4; ++d) { \
            _Pragma("unroll") for (int s_ = 0; s_ < 4; ++s_) { \
                const s16x4 vlo_ = __builtin_bit_cast(s16x4, __builtin_amdgcn_ds_read_tr16_b64_v4i16((LAS s16x4*)(vb + s_ * 16 * VP + d * 64))); \
                const s16x4 vhi_ = __builtin_bit_cast(s16x4, __builtin_amdgcn_ds_read_tr16_b64_v4i16((LAS s16x4*)(vb + (s_ * 16 + 4) * VP + d * 64))); \
                const bf16x8 vf = __builtin_shufflevector(vlo_, vhi_, 0, 1, 2, 3, 4, 5, 6, 7); \
                o[d] = MFMA32(vf, pf[s_], o[d]); } \
            __builtin_amdgcn_sched_barrier(0); } } while (0)
            const bool late = w >= 4; bool havep = false; int vprev = 0;
            bf16x8 pf[4];
#pragma unroll
            for (int i = 0; i < 4; ++i) pf[i] = (bf16x8){0, 0, 0, 0, 0, 0, 0, 0};
            ATT_LOAD((MODE == 2) ? NT - 1 : toff); ATT_STORE(0, 0); __syncthreads();
            int vcur = 0;
            for (int it = 0; it < NTe; ++it) {
                const int t = (MODE == 2) ? NT - 1 - it : it + toff, tn = (MODE == 2) ? t - 1 : t + 1; const bool more = it + 1 < NTe; const int buf = it & 1;
                if (more) ATT_LOAD(tn);
                if (havep) { ATT_PV(vprev); havep = false; }
                if (64 * t <= qmax) {
                    LAS const unsigned char* kb = lds + buf * KBUF + kfo;
                    f32x16 p0, p1;
#pragma unroll
                    for (int i = 0; i < 16; ++i) { p0[i] = 0.f; p1[i] = 0.f; }
#pragma unroll
                    for (int st = 0; st < NST; ++st) {
                        const bf16x8 k0 = *(LAS const bf16x8*)(kb + st * 32), k1 = *(LAS const bf16x8*)(kb + 32 * KP + st * 32);
                        p0 = MFMA32(k0, qf[st], p0); p1 = MFMA32(k1, qf[st], p1);
                        if ((st & 7) == 7) __builtin_amdgcn_sched_barrier(0);
                    }
                    if constexpr (MODE == 0) {
                        LAS const float* cb = (LAS const float*)(lds + OFF_C) + buf * 64 + 8 * hi;
#pragma unroll
                        for (int a = 0; a < 2; ++a) {
                            const f32x4 c0 = *(LAS const f32x4*)(cb + 16 * a), c1 = *(LAS const f32x4*)(cb + 16 * a + 4), c2 = *(LAS const f32x4*)(cb + 32 + 16 * a), c3 = *(LAS const f32x4*)(cb + 32 + 16 * a + 4);
#pragma unroll
                            for (int j = 0; j < 4; ++j) { p0[8 * a + j] -= c0[j]; p0[8 * a + 4 + j] -= c1[j]; p1[8 * a + j] -= c2[j]; p1[8 * a + 4 + j] -= c3[j]; }
                        }
                    }
                    if (64 * t + 63 >= qmin) {
#pragma unroll
                        for (int i = 0; i < 16; ++i) {
                            const int key = 64 * t + 16 * (i >> 3) + 8 * hi + (i & 7);
                            const bool m0 = (MODE == 2) ? (key >= qg) : (key > qg), m1 = (MODE == 2) ? (key + 32 >= qg) : (key + 32 > qg);
                            if (m0) p0[i] = -INFINITY; if (m1) p1[i] = -INFINITY;
                        }
                    }
                    if constexpr (MODE != 2) {
                        float mx = p0[0];
#pragma unroll
                        for (int i = 1; i < 16; ++i) mx = fmaxf(mx, p0[i]);
#pragma unroll
                        for (int i = 0; i < 16; ++i) mx = fmaxf(mx, p1[i]);
                        mx = fmaxf(mx, __shfl_xor(mx, 32));
                        const float m_new = fmaxf(m_run, mx);
                        const float alpha = fast_exp2(m_run - m_new);
                        m_run = m_new;
                        float rs = 0.f;
#pragma unroll
                        for (int i = 0; i < 16; ++i) { p0[i] = fast_exp2(p0[i] - m_new); p1[i] = fast_exp2(p1[i] - m_new); rs += p0[i] + p1[i]; }
                        l_run = l_run * alpha + rs;
                        if (!__all(alpha == 1.0f)) {
#pragma unroll
                            for (int d = 0; d < 4; ++d)
#pragma unroll
                                for (int i = 0; i < 16; ++i) o[d][i] *= alpha;
                        }
                    } else {
                        f32x16 l0, l1;
#pragma unroll
                        for (int i = 0; i < 16; ++i) {
                            const float e0_ = fast_exp2(fminf(p0[i], 100.f)), e1_ = fast_exp2(fminf(p1[i], 100.f));
                            l0[i] = fast_rcp(1.f + e0_); l1[i] = fast_rcp(1.f + e1_);
                            p0[i] = e0_ * l0[i]; p1[i] = e1_ * l1[i];
                            if ((i & 3) == 3) __builtin_amdgcn_sched_barrier(0);
                        }
                        __builtin_amdgcn_sched_barrier(0);
                        float own0 = 1.f, own1 = 1.f, own2 = 1.f, own3 = 1.f;
#pragma unroll
                        for (int j = 0; j < 8; ++j) { own0 *= l0[j]; own1 *= l0[8 + j]; own2 *= l1[j]; own3 *= l1[8 + j]; }
                        __builtin_amdgcn_sched_barrier(0);
                        const float oth0 = __shfl_xor(own0, 32), oth1 = __shfl_xor(own1, 32), oth2 = __shfl_xor(own2, 32), oth3 = __shfl_xor(own3, 32);
                        const float so2 = own3, so1 = own3 * own2, so0 = so1 * own1;
                        const float st3 = oth3, st2 = st3 * oth2, st1 = st2 * oth1, st0 = st1 * oth0;
                        const float e0 = carry * so0 * (hi ? st1 : st0), e1 = carry * so1 * (hi ? st2 : st1), e2 = carry * so2 * (hi ? st3 : st2), e3 = carry * (hi ? 1.f : st3);
                        {
                            float run = e0;
#pragma unroll
                            for (int jj = 0; jj < 8; ++jj) { const int i = 7 - jj; p0[i] *= run; run *= l0[i]; }
                            __builtin_amdgcn_sched_barrier(0);
                            run = e1;
#pragma unroll
                            for (int jj = 0; jj < 8; ++jj) { const int i = 15 - jj; p0[i] *= run; run *= l0[i]; }
                            __builtin_amdgcn_sched_barrier(0);
                            run = e2;
#pragma unroll
                            for (int jj = 0; jj < 8; ++jj) { const int i = 7 - jj; p1[i] *= run; run *= l1[i]; }
                            __builtin_amdgcn_sched_barrier(0);
                            run = e3;
#pragma unroll
                            for (int jj = 0; jj < 8; ++jj) { const int i = 15 - jj; p1[i] *= run; run *= l1[i]; }
                        }
                        carry *= so0 * own0 * st0;
                    }
                    { u32x4 w_; w_.x = pk2(p0[0], p0[1]); w_.y = pk2(p0[2], p0[3]); w_.z = pk2(p0[4], p0[5]); w_.w = pk2(p0[6], p0[7]); pf[0] = __builtin_bit_cast(bf16x8, w_);
                      w_.x = pk2(p0[8], p0[9]); w_.y = pk2(p0[10], p0[11]); w_.z = pk2(p0[12], p0[13]); w_.w = pk2(p0[14], p0[15]); pf[1] = __builtin_bit_cast(bf16x8, w_);
                      w_.x = pk2(p1[0], p1[1]); w_.y = pk2(p1[2], p1[3]); w_.z = pk2(p1[4], p1[5]); w_.w = pk2(p1[6], p1[7]); pf[2] = __builtin_bit_cast(bf16x8, w_);
                      w_.x = pk2(p1[8], p1[9]); w_.y = pk2(p1[10], p1[11]); w_.z = pk2(p1[12], p1[13]); w_.w = pk2(p1[14], p1[15]); pf[3] = __builtin_bit_cast(bf16x8, w_); }
                    __builtin_amdgcn_sched_barrier(0);
                    if (late) { havep = true; vprev = vcur; } else { ATT_PV(vcur); }
                }
                const int vnext = vcur == 2 ? 0 : vcur + 1;
                if (more) ATT_STORE(buf ^ 1, vnext);
                vcur = vnext;
                if constexpr (MODE == 2) {
                    const bool dead_w = __all(carry < 1e-37f);
                    if (lane == 0) ((LAS unsigned*)(lds + 131072 - 64))[(it & 1) * 8 + w] = dead_w ? 1u : 0u;
                }
                __syncthreads();
                if constexpr (MODE == 2) {
                    const u32x4 f0 = *(LAS const u32x4*)(lds + 131072 - 64 + (it & 1) * 32), f1 = *(LAS const u32x4*)(lds + 131072 - 64 + (it & 1) * 32 + 16);
                    if ((f0.x & f0.y & f0.z & f0.w & f1.x & f1.y & f1.z & f1.w) != 0u) break;
                }
            }
            if (havep) { ATT_PV(vprev); }
#undef ATT_PV
#undef ATT_LOAD
#undef ATT_STORE
            float inv = 1.f;
            if constexpr (MODE != 2) { const float l = l_run + __shfl_xor(l_run, 32); inv = 1.0f / l; }
            int r32o = r32, hio = hi; asm volatile("" : "+v"(r32o), "+v"(hio));
            bf16_t* orow = (O + (size_t)(b * SEQ + qmin) * DM + h * 128) + (unsigned)(r32o * DM + 4 * hio);
#pragma unroll
            for (int d = 0; d < 4; ++d)
#pragma unroll
                for (int g4 = 0; g4 < 4; ++g4) {
                    u32x2 w_; w_.x = pk2(o[d][4 * g4] * inv, o[d][4 * g4 + 1] * inv); w_.y = pk2(o[d][4 * g4 + 2] * inv, o[d][4 * g4 + 3] * inv);
                    *(u32x2*)(orow + 32 * d + 8 * g4) = w_;
                }
            __syncthreads();
        }
    }
}

DI void sgu_phase(LAS unsigned char* lds, const bf16_t* __restrict__ uv, const float* __restrict__ rowss, const float* __restrict__ vgain, const float* __restrict__ ws,
                  const float* __restrict__ bs, bf16_t* __restrict__ Gout, int vcu, int G, int wave_s) {
    constexpr int AP = 272, OFF_VT = 128 * AP, OFF_RS = 2 * 128 * AP;
    const int tid = opaque_tid(wave_s), lane = tid & 63, w = __builtin_amdgcn_readfirstlane(tid >> 6), r32 = lane & 31, hi = lane >> 5;
    for (int su = vcu; su < 256; su += G) {
        const int g = su >> 4, c0 = (su & 15) * 8;
        __syncthreads();
#pragma unroll
        for (int i = 0; i < 8; ++i) {
            const int ci = tid + 512 * i, t = ci >> 5, s4 = (ci & 31) * 4;
            f32x4 v = *(const f32x4*)(ws + (size_t)g * 16384 + t * 128 + s4);
#pragma unroll
            for (int j = 0; j < 4; ++j) if (s4 + j > t) v[j] = 0.f;
            u32x2 o; o.x = pk2(v[0], v[1]); o.y = pk2(v[2], v[3]);
            *(LAS u32x2*)(lds + t * AP + s4 * 2) = o;
        }
        const int rr = tid >> 2, part = tid & 3;
        u32x4 raw[4]; f32x4 pa, pb;
#define SGU_LOAD(ch_) do { const int rb_ = (c0 + (ch_)) * 128; \
        _Pragma("unroll") for (int i = 0; i < 4; ++i) { const int ci = tid + 512 * i; raw[i] = *(const u32x4*)(uv + (size_t)(rb_ + (ci >> 4)) * 4096 + 2048 + g * 128 + (ci & 15) * 8); } \
        pa = *(const f32x4*)(rowss + (size_t)(rb_ + rr) * 32 + part * 8); pb = *(const f32x4*)(rowss + (size_t)(rb_ + rr) * 32 + part * 8 + 4); } while (0)
        SGU_LOAD(0);
        for (int ch = 0; ch < 8; ++ch) {
            const int rbase = (c0 + ch) * 128;
            __syncthreads();
            {
                float ssum = ((pa[0] + pa[1]) + (pa[2] + pa[3])) + ((pb[0] + pb[1]) + (pb[2] + pb[3]));
                ssum += __shfl_xor(ssum, 1); ssum += __shfl_xor(ssum, 2);
                if (part == 0) ((LAS float*)(lds + OFF_RS))[rr] = __builtin_amdgcn_rsqf(ssum * (1.f / 2048.f) + EPS);
            }
            __syncthreads();
#pragma unroll
            for (int i = 0; i < 4; ++i) {
                const int ci = tid + 512 * i, s_ = ci >> 4, cc = (ci & 15) * 8;
                const float rstd = ((LAS const float*)(lds + OFF_RS))[s_];
                float f[8]; unpack8(raw[i], f);
#pragma unroll
                for (int j = 0; j < 8; j += 2) { const unsigned pw = pk2(f[j] * rstd, f[j + 1] * rstd);
                    *(LAS bf16_t*)(lds + OFF_VT + (cc + j) * AP + s_ * 2) = (bf16_t)(pw & 0xffffu); *(LAS bf16_t*)(lds + OFF_VT + (cc + j + 1) * AP + s_ * 2) = (bf16_t)(pw >> 16); }
            }
            if (ch + 1 < 8) SGU_LOAD(ch + 1);
            const int tb = w >> 1, cb0 = (w & 1) * 2, nsteps = 2 * (tb + 1);
            const int t = 32 * tb + r32; const size_t row = (size_t)rbase + t; const float bias = bs[g * 128 + t];
            u32x2 uu[2][4];
#pragma unroll
            for (int cbk = 0; cbk < 2; ++cbk)
#pragma unroll
                for (int g4 = 0; g4 < 4; ++g4) uu[cbk][g4] = *(const u32x2*)(uv + row * 4096 + g * 128 + 32 * (cb0 + cbk) + 8 * g4 + 4 * hi);
            __syncthreads();
            f32x16 a0, a1;
#pragma unroll
            for (int i = 0; i < 16; ++i) { a0[i] = 0.f; a1[i] = 0.f; }
            LAS const unsigned char* ap = lds + (32 * tb + r32) * AP + hi * 16;
            LAS const unsigned char* vp0 = lds + OFF_VT + (32 * cb0 + r32) * AP + hi * 16;
            for (int st = 0; st < nsteps; ++st) {
                const bf16x8 bf_ = *(LAS const bf16x8*)(ap + st * 32);
                const bf16x8 v0 = *(LAS const bf16x8*)(vp0 + st * 32), v1 = *(LAS const bf16x8*)(vp0 + 32 * AP + st * 32);
                a0 = MFMA32(v0, bf_, a0); a1 = MFMA32(v1, bf_, a1);
            }
#pragma unroll
            for (int cbk = 0; cbk < 2; ++cbk)
#pragma unroll
                for (int g4 = 0; g4 < 4; ++g4) {
                    const int c = 32 * (cb0 + cbk) + 8 * g4 + 4 * hi;
                    const f32x4 vg = *(const f32x4*)(vgain + g * 128 + c);
                    const u32x2 uq = uu[cbk][g4];
                    const float u0 = bf_lo(uq.x), u1 = bf_hi(uq.x), u2 = bf_lo(uq.y), u3 = bf_hi(uq.y);
                    const float m0 = (cbk ? a1[4 * g4] : a0[4 * g4]) * vg[0] + bias, m1 = (cbk ? a1[4 * g4 + 1] : a0[4 * g4 + 1]) * vg[1] + bias;
                    const float m2 = (cbk ? a1[4 * g4 + 2] : a0[4 * g4 + 2]) * vg[2] + bias, m3 = (cbk ? a1[4 * g4 + 3] : a0[4 * g4 + 3]) * vg[3] + bias;
                    u32x2 o; o.x = pk2(u0 * m0, u1 * m1); o.y = pk2(u2 * m2, u3 * m3);
                    *(u32x2*)(Gout + row * DM + g * 128 + c) = o;
                }
        }
#undef SGU_LOAD
    }
    __syncthreads();
}

DI void convact_phase(const bf16_t* __restrict__ up, const float* __restrict__ cw, const float* __restrict__ cbias, bf16_t* __restrict__ act, int bx, int G, int wave_s) {
    const int gtid = bx * 512 + opaque_tid(wave_s), GT = G * 512;
    constexpr int FCH = DFF / 8, RS = 16, NITEMS = (M_TOK / RS) * FCH, LDU = 2 * DFF;
    for (int it = gtid; it < NITEMS; it += GT) {
        const int fc = it % FCH, strip = it / FCH, f0 = fc * 8, r0 = strip * RS;
        float wg[3][8], wv[3][8], bg[8], bv[8];
#pragma unroll
        for (int tp = 0; tp < 3; ++tp) {
            const f32x4 a = *(const f32x4*)(cw + tp * LDU + f0), b = *(const f32x4*)(cw + tp * LDU + f0 + 4), c = *(const f32x4*)(cw + tp * LDU + DFF + f0), d = *(const f32x4*)(cw + tp * LDU + DFF + f0 + 4);
#pragma unroll
            for (int j = 0; j < 4; ++j) { wg[tp][j] = a[j]; wg[tp][4 + j] = b[j]; wv[tp][j] = c[j]; wv[tp][4 + j] = d[j]; }
        }
        {
            const f32x4 a = *(const f32x4*)(cbias + f0), b = *(const f32x4*)(cbias + f0 + 4), c = *(const f32x4*)(cbias + DFF + f0), d = *(const f32x4*)(cbias + DFF + f0 + 4);
#pragma unroll
            for (int j = 0; j < 4; ++j) { bg[j] = a[j]; bg[4 + j] = b[j]; bv[j] = c[j]; bv[4 + j] = d[j]; }
        }
        float g2[8], g1[8], v2[8], v1[8];
        if ((r0 & (SEQ - 1)) == 0) {
#pragma unroll
            for (int j = 0; j < 8; ++j) { g2[j] = 0.f; g1[j] = 0.f; v2[j] = 0.f; v1[j] = 0.f; }
        } else {
            const bf16_t* p2 = up + (size_t)(r0 - 2) * LDU + f0; const bf16_t* p1 = p2 + LDU;
            unpack8(*(const u32x4*)p2, g2); unpack8(*(const u32x4*)(p2 + DFF), v2); unpack8(*(const u32x4*)p1, g1); unpack8(*(const u32x4*)(p1 + DFF), v1);
        }
#pragma unroll 4
        for (int rr = 0; rr < RS; ++rr) {
            const bf16_t* p0 = up + (size_t)(r0 + rr) * LDU + f0;
            float gc[8], vc[8]; unpack8(*(const u32x4*)p0, gc); unpack8(*(const u32x4*)(p0 + DFF), vc);
            float o[8];
#pragma unroll
            for (int j = 0; j < 8; ++j) {
                const float yg = bg[j] + wg[0][j] * g2[j] + wg[1][j] * g1[j] + wg[2][j] * gc[j];
                const float yv = bv[j] + wv[0][j] * v2[j] + wv[1][j] * v1[j] + wv[2][j] * vc[j];
                o[j] = silu(yg) * yv;
                g2[j] = g1[j]; g1[j] = gc[j]; v2[j] = v1[j]; v1[j] = vc[j];
            }
            u32x4 w; w.x = pk2(o[0], o[1]); w.y = pk2(o[2], o[3]); w.z = pk2(o[4], o[5]); w.w = pk2(o[6], o[7]);
            *(u32x4*)(act + (size_t)(r0 + rr) * DFF + f0) = w;
        }
    }
}

DI void ffn_fix_phase(const float* __restrict__ halo, const float* __restrict__ cw, const float* __restrict__ cb, bf16_t* __restrict__ act, int bx, int G, int wave_s) {
    const int gtid = bx * 512 + opaque_tid(wave_s), GT = G * 512;
    constexpr int FQ = DFF / 4, NIT = 56 * FQ;
    for (int it = gtid; it < NIT; it += GT) {
        const int f = (it % FQ) * 4, k = it / FQ, pm = (k / 7) * 8 + 1 + (k % 7);
        f32x4 yr[2][2];
#pragma unroll
        for (int bj = 0; bj < 2; ++bj) {
            const float* hp = halo + ((size_t)((pm - 1) * 2 + bj) * 4) * DFF + f; const float* hc = halo + ((size_t)(pm * 2 + bj) * 4) * DFF + f;
            const f32x4 a2 = *(const f32x4*)(hp + 2 * DFF), a1 = *(const f32x4*)(hp + 3 * DFF), c0 = *(const f32x4*)hc, c1 = *(const f32x4*)(hc + DFF);
            const int c = bj * DFF + f;
            const f32x4 w0 = *(const f32x4*)(cw + c), w1 = *(const f32x4*)(cw + 2 * DFF + c), w2 = *(const f32x4*)(cw + 4 * DFF + c), bb = *(const f32x4*)(cb + c);
            yr[bj][0] = bb + w0 * a2 + w1 * a1 + w2 * c0; yr[bj][1] = bb + w0 * a1 + w1 * c0 + w2 * c1;
        }
#pragma unroll
        for (int rr = 0; rr < 2; ++rr) { u32x2 w; w.x = pk2(silu(yr[0][rr][0]) * yr[1][rr][0], silu(yr[0][rr][1]) * yr[1][rr][1]); w.y = pk2(silu(yr[0][rr][2]) * yr[1][rr][2], silu(yr[0][rr][3]) * yr[1][rr][3]);
            *(u32x2*)(act + (size_t)(pm * 256 + rr) * DFF + f) = w; }
    }
}

#define XB_XCNT(j)  (256  + 64 * (j))
#define XB_XSUB(j)  (1280 + 64 * (j))
#define XB_XGEN(j)  (2304 + 64 * (j))
#define XB_TOP      3328
#define XB_TOPGEN   3392
#define XCD_BAR_WORDS 3456
DI unsigned xb_ld(unsigned* p) { return __hip_atomic_load(p, __ATOMIC_RELAXED, __HIP_MEMORY_SCOPE_AGENT); }
DI unsigned xb_add(unsigned* p, unsigned v) { return __hip_atomic_fetch_add(p, v, __ATOMIC_RELAXED, __HIP_MEMORY_SCOPE_AGENT); }
DI unsigned xb_xcc_id() { return (unsigned)__builtin_amdgcn_s_getreg((3 << 11) | 20) & 0xFu; }
#define XB_SPIN(cond) do { unsigned _sp = 0; while (cond) { __builtin_amdgcn_s_sleep(1); if (++_sp > (1u << 24)) break; } } while (0)
DI void xcd_barrier(unsigned* bar, volatile LAS unsigned* st, int tid) {
    asm volatile("s_waitcnt vmcnt(0) lgkmcnt(0)" ::: "memory");
    __syncthreads();
    if (tid == 0) {
        const unsigned x = xb_xcc_id();
        unsigned nloc = st[0], nx = st[1];
        if (nloc == 0u) {
            const unsigned G = gridDim.x; unsigned sp = 0;
            for (;;) {
                unsigned sum = 0u, cnt = 0u, mine = 0u;
#pragma unroll
                for (unsigned j = 0; j < 16; ++j) { const unsigned c = xb_ld(&bar[XB_XCNT(j)]); sum += c; cnt += (c > 0u) ? 1u : 0u; mine = (j == x) ? c : mine; }
                nloc = mine > 0u ? mine : 1u; nx = cnt > 0u ? cnt : 1u;
                if (sum == G) break;
                __builtin_amdgcn_s_sleep(1); if (++sp > (1u << 22)) break;
            }
            st[0] = nloc; st[1] = nx;
        }
        const unsigned old = xb_add(&bar[XB_XSUB(x)], 1u);
        const unsigned gen = old / nloc;
        if (old + 1u == (gen + 1u) * nloc) {
            __builtin_amdgcn_fence(__ATOMIC_RELEASE, "agent");
            asm volatile("s_waitcnt vmcnt(0)" ::: "memory");
            const unsigned og = xb_add(&bar[XB_TOP], 1u);
            const unsigned tg = og / nx;
            if (og + 1u == (tg + 1u) * nx) xb_add(&bar[XB_TOPGEN], 1u);
            else XB_SPIN(xb_ld(&bar[XB_TOPGEN]) == tg);
            __builtin_amdgcn_fence(__ATOMIC_ACQUIRE, "agent");
            xb_add(&bar[XB_XGEN(x)], 1u);
            asm volatile("s_waitcnt vmcnt(0)" ::: "memory");
        } else {
            XB_SPIN(xb_ld(&bar[XB_XGEN(x)]) == gen);
            __builtin_amdgcn_fence(__ATOMIC_ACQUIRE, "agent");
            asm volatile("s_waitcnt vmcnt(0)" ::: "memory");
        }
    }
    __syncthreads();
}

#define SLACK_IDS(nwg_) const int rounds_ = ((nwg_) + G - 1) / G, nfull_ = (nwg_) - (rounds_ - 1) * G; const bool all_ = nfull_ == G; \
        const bool mine_ = all_ || bx >= nfull_; const int tid_ = opaque_tid(wave_s), lane_ = tid_ & 63, wv_ = tid_ >> 6; \
        const int sgw_ = (all_ ? bx : bx - nfull_) * 8 + wv_, sngw_ = (all_ ? G : G - nfull_) * 8; LAS float* sscr_ = (LAS float*)(lds + wv_ * 8704)
#ifndef REP_ATT
#define REP_ATT 1
#endif
#ifndef REP_CACT
#define REP_CACT 1
#endif
#ifndef REP_CONV
#define REP_CONV 1
#endif
#ifndef REP_NORM
#define REP_NORM 1
#endif
struct Args { const float* in[30]; float* out; unsigned char* ws; };
constexpr int LDS_BYTES = 131072 + 64 + 8192 + 8192 + 8192;

__global__ void __launch_bounds__(512, 2) mega_fwd(Args args) {
    extern __shared__ __attribute__((aligned(16))) unsigned char lds_raw[];
    LAS unsigned char* lds = (LAS unsigned char*)lds_raw;
    cg::grid_group grid = cg::this_grid();
#define GSYNC_LIB() do { asm volatile("s_waitcnt vmcnt(0) lgkmcnt(0)" ::: "memory"); grid.sync(); } while (0)
#define GSYNC() xcd_barrier((unsigned*)args.ws, (volatile LAS unsigned*)(lds + 131072), opaque_tid(wave_s))
    const int G = gridDim.x, bx = blockIdx.x;
    const int wave_s = __builtin_amdgcn_readfirstlane((int)(threadIdx.x >> 6));
    const int vcu = (G % 8 == 0) ? (bx % 8) * (G / 8) + bx / 8 : bx;
    unsigned char* ws = args.ws;
    float* out = args.out;
    const float* x = args.in[0]; const int* positions = (const int*)args.in[1];
    bf16_t* XB = (bf16_t*)(ws + WS_XB); unsigned char* BIG = ws + WS_BIG; unsigned char* ACT = ws + WS_ACT;
    float* flog = (float*)(ws + WS_FLOG); float* cum = (float*)(ws + WS_CUM); float* krope = (float*)(ws + WS_KROPE); float* rcs = (float*)(ws + WS_RCS); float* rsn = (float*)(ws + WS_RSN);

    if (threadIdx.x < 2) ((volatile LAS unsigned*)(lds + 131072))[threadIdx.x] = 0u;
    if (blockIdx.x == 0) for (int i = threadIdx.x; i < XCD_BAR_WORDS; i += 512) ((unsigned*)args.ws)[i] = 0u;
    {
        const int tid = opaque_tid(wave_s), lane = tid & 63, wave = tid >> 6, gw = vcu * 8 + wave, NGW = G * 8;
        LAS float* scr = (LAS float*)(lds + wave * 8704);
        for (int i = bx * 512 + tid; i < M_TOK * 32; i += G * 512) {
            const float ang = (float)positions[i >> 5] * exp2f(-(float)(i & 31) * (13.287712379549449f / 32.f));
            const double ad = (double)ang; const double nrev = rint(ad * 0.15915494309189535); const float red = (float)(ad - nrev * 6.283185307179586);
            rcs[i] = __cosf(red); rsn[i] = __sinf(red);
        }
#define CONV(src, gain, dstoff, K, N, Npad) convert_matrix(src, gain, (bf16_t*)(ws + (dstoff)), K, N, Npad, scr, gw, NGW, lane)
        for (int rep_ = 0; rep_ < REP_CONV; ++rep_) {
        CONV(args.in[4], args.in[2] + 0 * DM, W_FOX_IN, 2048, 6160, 6400);
        CONV(args.in[8], nullptr, W_FOX_OUT, 2048, 2048, 2048);
        CONV(args.in[9], args.in[2] + 1 * DM, W_MLA_IN, 2048, 1088, 1280);
        CONV(args.in[12], args.in[10], W_MLA_QB, 512, 3072, 3072);
        CONV(args.in[13], args.in[11], W_MLA_KVB, 512, 4096, 4096);
        CONV(args.in[16], nullptr, W_MLA_OUT, 2048, 2048, 2048);
        for (int l = 0; l < 4; ++l) {
            convert_matrix(args.in[26] + (size_t)l * 2048 * 11264, args.in[3] + l * DM, (bf16_t*)(ws + W_UP + (size_t)l * 44 * MiB), 2048, 11264, 11264, scr, gw, NGW, lane, true);
            if (l < 3) CONV(args.in[29] + (size_t)l * 5632 * 2048, nullptr, W_DOWN + (size_t)l * 22 * MiB, 5632, 2048, 2048);
        }
        }
#undef CONV
        norm_phase(x, XB, (float*)(ws + WS_RSH), vcu, G, wave_s);
    }
    GSYNC_LIB();
    if (threadIdx.x == 0) (void)xb_add(&((unsigned*)args.ws)[XB_XCNT(xb_xcc_id())], 1u);

    for (int layer_ = 0; layer_ < 4; ++layer_) {
        const int layer = opaque_s(layer_);
        unsigned char* ws = opaque_p(args.ws); float* out = opaque_p(args.out);
        const int G = opaque_s((int)gridDim.x), bx = opaque_s((int)blockIdx.x);
        const int vcu = (G % 8 == 0) ? (bx % 8) * (G / 8) + bx / 8 : bx;
        bf16_t* XB = (bf16_t*)(ws + WS_XB); unsigned char* BIG = ws + WS_BIG; unsigned char* ACT = ws + WS_ACT;
            float* flog = (float*)(ws + WS_FLOG); float* cum = (float*)(ws + WS_CUM); float* krope = (float*)(ws + WS_KROPE); float* rcs = (float*)(ws + WS_RCS); float* rsn = (float*)(ws + WS_RSN); float* rsp = (float*)(ws + WS_RSP); float* rssgu = (float*)(ws + WS_RSSGU); float* rsh = (float*)(ws + WS_RSH);
        bf16_t* Obuf = (bf16_t*)ACT;
        const bf16_t* Wout;
        if (layer == 0) {
            bf16_t* QKV = (bf16_t*)BIG; bf16_t* KN = (bf16_t*)(BIG + 192 * MiB); bf16_t* VT = (bf16_t*)(BIG + 288 * MiB);
            { pg8::Gemm g{XB, DM, (const bf16_t*)(ws + W_FOX_IN), DM, M_TOK, 6400, DM}; pg8::StaticOrder S; S.init(M_TOK, 6400, G, bx);
              const int pmb_ = (bx & 7) * 8; pg8::rstd_tab_build(rsh, pmb_, (LAS float*)(lds + 131072 + 64 + 8192), opaque_tid(wave_s));
              pg8::EpiQKV<true> E{QKV, KN, args.in[7], flog, rsh, (LAS float*)(lds + 131072 + 64), (LAS float*)(lds + 131072 + 64 + 8192), pmb_}; pg8::gemm_phase(lds, g, S, E, wave_s); }
            { SLACK_IDS(64 * 25);
              if (mine_) { convert_matrix(args.in[17], args.in[2] + 2 * DM, (bf16_t*)(ws + W_SB_IN), 2048, 6144, 6144, sscr_, sgw_, sngw_, lane_);
                           convert_matrix(args.in[21], args.in[2] + 3 * DM, (bf16_t*)(ws + W_SGU_IN), 2048, 4096, 4096, sscr_, sgw_, sngw_, lane_); } }
            GSYNC();
            for (int rep_ = 0; rep_ < REP_ATT; ++rep_) { kvprep_phase<0>(lds, QKV, KN, VT, args.in[7], flog, args.in[5], cum, nullptr, nullptr, nullptr, vcu, G, wave_s); __syncthreads(); }
            GSYNC();
            for (int rep_ = 0; rep_ < REP_ATT; ++rep_) { attn_phase<0>(lds, QKV, 6144, 128, KN, QKV + 4096, 6144, 128, cum, args.in[6], args.in[7], nullptr, Obuf, vcu, G, wave_s); __syncthreads(); }
            Wout = (const bf16_t*)(ws + W_FOX_OUT);
        } else if (layer == 1) {
            bf16_t* Cb = (bf16_t*)(ACT + 128 * MiB); bf16_t* Qb = (bf16_t*)BIG; bf16_t* KN = (bf16_t*)(BIG + 96 * MiB); bf16_t* VT = nullptr; bf16_t* KV = (bf16_t*)(BIG + 192 * MiB);
            { pg8::Gemm g{XB, DM, (const bf16_t*)(ws + W_MLA_IN), DM, M_TOK, 1280, DM}; pg8::StaticOrder S; S.init(M_TOK, 1280, G, bx);
              const int pmb_ = (bx & 7) * 8; pg8::rstd_tab_build(rsh, pmb_, (LAS float*)(lds + 131072 + 64 + 8192), opaque_tid(wave_s));
              pg8::EpiMlaIn E{Cb, rsp, krope, rsh, (LAS float*)(lds + 131072 + 64 + 8192), pmb_}; pg8::gemm_phase(lds, g, S, E, wave_s); }
            { SLACK_IDS(64 * 5);
              if (mine_) { convert_matrix(args.in[20], nullptr, (bf16_t*)(ws + W_SB_OUT), 2048, 2048, 2048, sscr_, sgw_, sngw_, lane_);
                           convert_matrix(args.in[25], nullptr, (bf16_t*)(ws + W_SGU_OUT), 2048, 2048, 2048, sscr_, sgw_, sngw_, lane_);
                           convert_matrix(args.in[29] + (size_t)3 * 5632 * 2048, nullptr, (bf16_t*)(ws + W_DOWN + (size_t)3 * 22 * MiB), 5632, 2048, 2048, sscr_, sgw_, sngw_, lane_); } }
            GSYNC();
            { pg8::Gemm g{Cb, 1024, (const bf16_t*)(ws + W_MLA_QB), 512, M_TOK, 3072, 512}; pg8::StaticOrder S; S.init(M_TOK, 3072, G, bx);
              pg8::rstd512_tab_build(rsp, (bx & 7) * 8, (LAS float*)(lds + 131072 + 64 + 8192), (LAS float*)(lds + 131072 + 64 + 16384), opaque_tid(wave_s));
              pg8::EpiStore<0, 1, false> E{Qb, 3072, rsp, nullptr, 0, (LAS float*)(lds + 131072 + 64 + 8192), (bx & 7) * 8}; pg8::gemm_phase(lds, g, S, E, wave_s); }
            { pg8::Gemm g{Cb + 512, 1024, (const bf16_t*)(ws + W_MLA_KVB), 512, M_TOK, 4096, 512}; pg8::StaticOrder S; S.init(M_TOK, 4096, G, bx);
              pg8::EpiMlaKV E{KV, KN, args.in[15], rsp + 8, (LAS float*)(lds + 131072 + 64), (LAS float*)(lds + 131072 + 64 + 16384), (bx & 7) * 8}; pg8::gemm_phase(lds, g, S, E, wave_s); }
            kvprep_phase<1>(lds, KV, KN, VT, args.in[15], nullptr, nullptr, nullptr, krope, rcs, rsn, vcu, G, wave_s);
            GSYNC();
            for (int rep_ = 0; rep_ < REP_ATT; ++rep_) { attn_phase<1>(lds, Qb, 3072, 192, KN, KV + 128, 4096, 256, nullptr, args.in[14], rcs, rsn, Obuf, vcu, G, wave_s); __syncthreads(); }
            Wout = (const bf16_t*)(ws + W_MLA_OUT);
        } else if (layer == 2) {
            bf16_t* QKV = (bf16_t*)BIG; bf16_t* KN = (bf16_t*)(BIG + 192 * MiB); bf16_t* VT = (bf16_t*)(BIG + 288 * MiB);
            { pg8::Gemm g{XB, DM, (const bf16_t*)(ws + W_SB_IN), DM, M_TOK, 6144, DM}; pg8::StaticOrder S; S.init(M_TOK, 6144, G, bx);
              const int pmb_ = (bx & 7) * 8; pg8::rstd_tab_build(rsh, pmb_, (LAS float*)(lds + 131072 + 64 + 8192), opaque_tid(wave_s));
              pg8::EpiQKV<false> E{QKV, KN, args.in[19], nullptr, rsh, (LAS float*)(lds + 131072 + 64), (LAS float*)(lds + 131072 + 64 + 8192), pmb_}; pg8::gemm_phase(lds, g, S, E, wave_s); }
            GSYNC();
            for (int rep_ = 0; rep_ < REP_ATT; ++rep_) { attn_phase<2>(lds, QKV, 6144, 128, KN, QKV + 4096, 6144, 128, nullptr, args.in[18], nullptr, nullptr, Obuf, vcu, G, wave_s); __syncthreads(); }
            Wout = (const bf16_t*)(ws + W_SB_OUT);
        } else {
            bf16_t* UV = (bf16_t*)BIG;
            { pg8::Gemm g{XB, DM, (const bf16_t*)(ws + W_SGU_IN), DM, M_TOK, 4096, DM}; pg8::StaticOrder S; S.init(M_TOK, 4096, G, bx);
              const int pmb_ = (bx & 7) * 8; pg8::rstd_tab_build(rsh, pmb_, (LAS float*)(lds + 131072 + 64 + 8192), opaque_tid(wave_s));
              pg8::EpiStore<1, 2, true> E{UV, 4096, rsh, rssgu, 8, (LAS float*)(lds + 131072 + 64 + 8192), pmb_}; pg8::gemm_phase(lds, g, S, E, wave_s); }
            GSYNC();
            for (int rep_ = 0; rep_ < REP_ATT; ++rep_) { sgu_phase(lds, UV, rssgu, args.in[22], args.in[23], args.in[24], Obuf, vcu, G, wave_s); __syncthreads(); }
            Wout = (const bf16_t*)(ws + W_SGU_OUT);
        }
        GSYNC();
        { pg8::Gemm g{Obuf, DM, Wout, DM, M_TOK, DM, DM}; pg8::StaticOrder S; S.init(M_TOK, DM, G, bx);
          if (layer == 0) { pg8::EpiResid<true, false> E{x, out, XB, rsh}; pg8::gemm_phase(lds, g, S, E, wave_s); }
          else { pg8::EpiResid<false, false> E{x, out, XB, rsh}; pg8::gemm_phase(lds, g, S, E, wave_s); } }
        GSYNC();
        bf16_t* AC = (bf16_t*)ACT; float* halo = (float*)(ws + WS_HALO);
        const float* cwl = args.in[27] + (size_t)layer * 3 * 2 * DFF; const float* cbl = args.in[28] + (size_t)layer * 2 * DFF;
        { pg8::Gemm g{XB, DM, (const bf16_t*)(ws + W_UP + (size_t)layer * 44 * MiB), DM, M_TOK, 2 * DFF, DM}; pg8::StaticOrder S; S.init(M_TOK, 2 * DFF, G, bx);
          const int pmb_ = (bx & 7) * 8; pg8::rstd_tab_build(rsh, pmb_, (LAS float*)(lds + 131072 + 64 + 8192), opaque_tid(wave_s));
              pg8::EpiUpConv E{AC, rsh, cwl, cbl, halo, (LAS float*)(lds + 131072 + 64), (LAS float*)(lds + 131072 + 64 + 8192), pmb_}; pg8::gemm_phase(lds, g, S, E, wave_s); }
        GSYNC();
        ffn_fix_phase(halo, cwl, cbl, AC, bx, G, wave_s);
        GSYNC();
        { pg8::Gemm g{AC, DFF, (const bf16_t*)(ws + W_DOWN + (size_t)layer * 22 * MiB), DFF, M_TOK, DM, DFF}; pg8::StaticOrder S; S.init(M_TOK, DM, G, bx);
          if (layer < 3) { pg8::EpiResid<false, false> E{x, out, XB, rsh}; pg8::gemm_phase(lds, g, S, E, wave_s); }
          else { pg8::EpiResid<false, true> E{x, out, XB, rsh}; pg8::gemm_phase(lds, g, S, E, wave_s); } }
        if (layer < 3) GSYNC();
    }
}

extern "C" void kernel_launch(void* const* d_in, const int* in_sizes, int n_in, void* d_out, int out_size, void* d_ws, size_t ws_size, hipStream_t stream) {
    static int grid = 0;
    if (grid == 0) {
        if (n_in != 30 || ws_size < WS_END) { fprintf(stderr, "kernel_launch: unexpected problem (n_in %d, ws %zu)\n", n_in, ws_size); grid = -1; return; }
        int dev = 0, cus = 0, per_cu = 0;
        hipGetDevice(&dev);
        hipDeviceGetAttribute(&cus, hipDeviceAttributeMultiprocessorCount, dev);
        hipFuncSetAttribute((const void*)mega_fwd, hipFuncAttributeMaxDynamicSharedMemorySize, LDS_BYTES);
        hipOccupancyMaxActiveBlocksPerMultiprocessor(&per_cu, (const void*)mega_fwd, 512, LDS_BYTES);
        if (per_cu < 1) { fprintf(stderr, "kernel_launch: occupancy query returned %d\n", per_cu); per_cu = 1; }
        grid = cus * per_cu;
    }
    if (grid < 0) return;
    Args a{};
    for (int i = 0; i < 30; ++i) a.in[i] = (const float*)d_in[i];
    a.out = (float*)d_out; a.ws = (unsigned char*)d_ws;
    void* kargs[] = {&a};
    hipError_t e = hipLaunchCooperativeKernel((const void*)mega_fwd, dim3(grid), dim3(512), kargs, LDS_BYTES, stream);
    if (e != hipSuccess) fprintf(stderr, "cooperative launch failed: %s (grid %d)\n", hipGetErrorString(e), grid);
}
```
